# Optimizing an MI355X kernel written in HIP

```python
import math
import jax
import jax.numpy as jnp
from jax import lax
import numpy as np

D_MODEL = 1024
BATCH = 8
SEQ = 4096
DEPTH = 4

GRID_W = 64
CTX_LEN = 256
ROPE_THETA = 10000.0
RMS_EPS = 1e-6
Q_BLOCK = 128
HEAD_DIM = 64
N_BRANCH = 4
BRANCH_HEADS = D_MODEL // (N_BRANCH * HEAD_DIM)
BRANCH_WIDTH = BRANCH_HEADS * HEAD_DIM
NA_WIN_H = 8
NA_WIN_W = 16
GQA_KV_HEADS = 2
DIFF_QK_DIM = 32
MLA_Q_RANK = D_MODEL // 4
MLA_KV_RANK = D_MODEL // 8
MLA_NOPE_DIM = 64
MLA_ROPE_DIM = 32
MLA_QK_DIM = MLA_NOPE_DIM + MLA_ROPE_DIM
D_FF = 128 * ((8 * D_MODEL // 3 + 127) // 128)
N_MOD = 9
NA_COLS = 3 * BRANCH_WIDTH
GQA_COLS = BRANCH_WIDTH + 2 * GQA_KV_HEADS * HEAD_DIM
DIFF_COLS = 2 * BRANCH_HEADS * 2 * DIFF_QK_DIM + BRANCH_WIDTH
MLA_COLS = MLA_Q_RANK + MLA_KV_RANK + MLA_ROPE_DIM
IN_COLS = NA_COLS + GQA_COLS + DIFF_COLS + MLA_COLS
IN_SPLITS = (NA_COLS, NA_COLS + GQA_COLS, NA_COLS + GQA_COLS + DIFF_COLS)

kernel_name = 'hybrid_gated_multimixer_diffusion_trunk'


def rms_norm(x, g):
    xf = x.astype(jnp.float32)
    y = xf * lax.rsqrt(jnp.mean(jnp.square(xf), axis=-1, keepdims=True) + RMS_EPS)
    return (y * g.astype(jnp.float32)).astype(x.dtype)


def modulate(x, g, shift, scale):
    return rms_norm(x, g) * (1 + scale[:, None, :]) + shift[:, None, :]


def ffn_half_step(x, g, shift, scale, gate, w1, w3, w2):
    h = modulate(x, g, shift, scale)
    return x + 0.5 * gate[:, None, :] * ((jax.nn.silu(h @ w1) * (h @ w3)) @ w2)


def axial_rope_tables(n_tok, rot_dim):
    t = jnp.arange(n_tok, dtype=jnp.int32)
    row = (t // GRID_W).astype(jnp.float32)
    col = (t % GRID_W).astype(jnp.float32)
    n_freq = rot_dim // 4
    inv = ROPE_THETA ** (-jnp.arange(n_freq, dtype=jnp.float32) / n_freq)
    ar = row[:, None] * inv[None, :]
    ac = col[:, None] * inv[None, :]
    ang = jnp.concatenate([ar, ar, ac, ac], axis=-1)
    return jnp.cos(ang), jnp.sin(ang)


def apply_axial_rope(x, cos, sin):
    xf = x.astype(jnp.float32)
    x1, x2, x3, x4 = jnp.split(xf, 4, axis=-1)
    rot = jnp.concatenate([-x2, x1, -x4, x3], axis=-1)
    shp = (x.shape[1],) + (1,) * (x.ndim - 3) + (x.shape[-1],)
    return (xf * cos.reshape(shp) + rot * sin.reshape(shp)).astype(x.dtype)


def ctx_attention(q, k, v, scale):
    s = jnp.einsum('bqgrd,bkgd->bgrqk', q, k, preferred_element_type=jnp.float32) * scale
    p = jax.nn.softmax(s, axis=-1).astype(v.dtype)
    return jnp.einsum('bgrqk,bkgd->bqgrd', p, v)


def joint_attention(q_pos, q_nopos, k_lat, v_lat, k_ctx, v_ctx, scale):
    B, S, G, R, dk = q_pos.shape
    nb = S // Q_BLOCK

    def to_blocks(q):
        return jnp.moveaxis(q.reshape(B, nb, Q_BLOCK, G, R, dk), 1, 0)

    def block(qs):
        qb, qcb = qs
        s_lat = jnp.einsum('bqgrd,bkgd->bgrqk', qb, k_lat, preferred_element_type=jnp.float32)
        s_ctx = jnp.einsum('bqgrd,bkgd->bgrqk', qcb, k_ctx, preferred_element_type=jnp.float32)
        p = jax.nn.softmax(jnp.concatenate([s_lat, s_ctx], axis=-1) * scale, axis=-1).astype(v_lat.dtype)
        return (jnp.einsum('bgrqk,bkgd->bqgrd', p[..., :S], v_lat)
                + jnp.einsum('bgrqk,bkgd->bqgrd', p[..., S:], v_ctx))

    o = lax.map(block, (to_blocks(q_pos), to_blocks(q_nopos)))
    return jnp.moveaxis(o, 0, 1).reshape(B, S, G, R, v_lat.shape[-1])


def neighbourhood_attention(q, k, v, k_ctx, v_ctx, rpb, scale):
    B, S, H, d = q.shape
    rows = S // GRID_W
    wh = min(NA_WIN_H, rows)
    r = jnp.arange(rows)
    r0 = jnp.clip(r - wh // 2, 0, rows - wh)
    key_rows = r0[:, None] + jnp.arange(wh)[None, :]
    col = jnp.arange(GRID_W)
    c0 = jnp.clip(col - NA_WIN_W // 2, 0, GRID_W - NA_WIN_W)
    in_win = (col[None, :] >= c0[:, None]) & (col[None, :] < c0[:, None] + NA_WIN_W)
    qg = q.reshape(B, rows, GRID_W, H, d)
    kg = k.reshape(B, rows, GRID_W, H, d)[:, key_rows]
    vg = v.reshape(B, rows, GRID_W, H, d)[:, key_rows]
    s_nb = jnp.einsum('brqhd,brakhd->bhrqak', qg, kg, preferred_element_type=jnp.float32) * scale
    d_row = key_rows - r[:, None] + (NA_WIN_H - 1)
    d_col = jnp.clip(col[None, :] - col[:, None], -(NA_WIN_W - 1), NA_WIN_W - 1) + (NA_WIN_W - 1)
    bias = rpb[:, d_row[:, None, :, None], d_col[None, :, None, :]]
    s_nb = jnp.where(in_win[:, None, :], s_nb + bias.astype(jnp.float32), -jnp.inf)
    s_nb = s_nb.reshape(B, H, rows, GRID_W, wh * GRID_W)
    s_ctx = jnp.einsum('brqhd,blhd->bhrql', qg, k_ctx, preferred_element_type=jnp.float32) * scale
    p = jax.nn.softmax(jnp.concatenate([s_nb, s_ctx], axis=-1), axis=-1).astype(v.dtype)
    p_nb = p[..., :wh * GRID_W].reshape(B, H, rows, GRID_W, wh, GRID_W)
    o = (jnp.einsum('bhrqak,brakhd->brqhd', p_nb, vg)
         + jnp.einsum('bhrql,blhd->brqhd', p[..., wh * GRID_W:], v_ctx))
    return o.reshape(B, S, H, d)


def mixer_na(p_lat, p_ctx, g_q, g_k, rpb, need_ctx):
    def project(p):
        b, n = p.shape[:2]
        p = p.reshape(b, n, 3, BRANCH_HEADS, HEAD_DIM)
        return rms_norm(p[:, :, 0], g_q), rms_norm(p[:, :, 1], g_k), p[:, :, 2]
    q, k, v = project(p_lat)
    qc, kc, vc = project(p_ctx)
    scale = HEAD_DIM ** -0.5
    o_lat = neighbourhood_attention(q, k, v, kc, vc, rpb, scale).reshape(p_lat.shape[0], p_lat.shape[1], BRANCH_WIDTH)
    o_ctx = None
    if need_ctx:
        o_ctx = ctx_attention(qc[:, :, :, None], kc, vc, scale).reshape(p_ctx.shape[0], p_ctx.shape[1], BRANCH_WIDTH)
    return o_lat, o_ctx


def mixer_gqa(p_lat, p_ctx, g_q, g_k, cos, sin, need_ctx):
    R = BRANCH_HEADS // GQA_KV_HEADS
    def project(p):
        b, n = p.shape[:2]
        q, k, v = jnp.split(p, [BRANCH_WIDTH, BRANCH_WIDTH + GQA_KV_HEADS * HEAD_DIM], axis=-1)
        q = rms_norm(q.reshape(b, n, GQA_KV_HEADS, R, HEAD_DIM), g_q)
        k = rms_norm(k.reshape(b, n, GQA_KV_HEADS, HEAD_DIM), g_k)
        return q, k, v.reshape(b, n, GQA_KV_HEADS, HEAD_DIM)
    q, k, v = project(p_lat)
    qc, kc, vc = project(p_ctx)
    scale = HEAD_DIM ** -0.5
    o = joint_attention(apply_axial_rope(q, cos, sin), q, apply_axial_rope(k, cos, sin), v, kc, vc, scale)
    o_lat = o.reshape(p_lat.shape[0], p_lat.shape[1], BRANCH_WIDTH)
    o_ctx = None
    if need_ctx:
        o_ctx = ctx_attention(qc, kc, vc, scale).reshape(p_ctx.shape[0], p_ctx.shape[1], BRANCH_WIDTH)
    return o_lat, o_ctx


def mixer_diff(p_lat, p_ctx, g_q, g_k, lam_vecs, g_sub, lam_init, cos, sin, need_ctx):
    H, dq = BRANCH_HEADS, DIFF_QK_DIM
    def project(p):
        b, n = p.shape[:2]
        q, k, v = jnp.split(p, [H * 2 * dq, 2 * H * 2 * dq], axis=-1)
        q = rms_norm(q.reshape(b, n, H, 2, dq), g_q)
        k = rms_norm(k.reshape(b, n, H, 2, dq), g_k)
        return q, k, v.reshape(b, n, H, HEAD_DIM)
    q, k, v = project(p_lat)
    qc, kc, vc = project(p_ctx)
    lv = lam_vecs.astype(jnp.float32)
    lam = (jnp.exp(jnp.sum(lv[0] * lv[1])) - jnp.exp(jnp.sum(lv[2] * lv[3])) + lam_init).astype(v.dtype)
    scale = dq ** -0.5

    def combine(o1, o2):
        b, n = o1.shape[:2]
        return (rms_norm(o1 - lam * o2, g_sub) * (1 - lam_init)).reshape(b, n, BRANCH_WIDTH)

    qr, kr = apply_axial_rope(q, cos, sin), apply_axial_rope(k, cos, sin)
    o1 = joint_attention(qr[:, :, :, 0:1], q[:, :, :, 0:1], kr[:, :, :, 0], v, kc[:, :, :, 0], vc, scale)
    o2 = joint_attention(qr[:, :, :, 1:2], q[:, :, :, 1:2], kr[:, :, :, 1], v, kc[:, :, :, 1], vc, scale)
    o_lat = combine(o1, o2)
    o_ctx = None
    if need_ctx:
        o_ctx = combine(ctx_attention(qc[:, :, :, 0:1], kc[:, :, :, 0], vc, scale),
                        ctx_attention(qc[:, :, :, 1:2], kc[:, :, :, 1], vc, scale))
    return o_lat, o_ctx


def mixer_mla(p_lat, p_ctx, g_cq, g_ckv, w_uq, w_ukv, g_q, g_k, cos, sin, need_ctx):
    H = BRANCH_HEADS
    def project(p):
        b, n = p.shape[:2]
        c_q, c_kv, k_rope = jnp.split(p, [MLA_Q_RANK, MLA_Q_RANK + MLA_KV_RANK], axis=-1)
        q = (rms_norm(c_q, g_cq) @ w_uq).reshape(b, n, H, MLA_QK_DIM)
        kv = (rms_norm(c_kv, g_ckv) @ w_ukv).reshape(b, n, H, MLA_NOPE_DIM + HEAD_DIM)
        k = jnp.concatenate([kv[..., :MLA_NOPE_DIM],
                             jnp.broadcast_to(k_rope[:, :, None, :], (b, n, H, MLA_ROPE_DIM))], axis=-1)
        return rms_norm(q, g_q)[:, :, :, None], rms_norm(k, g_k), kv[..., MLA_NOPE_DIM:]

    def rope_tail(t):
        return jnp.concatenate([t[..., :MLA_NOPE_DIM], apply_axial_rope(t[..., MLA_NOPE_DIM:], cos, sin)], axis=-1)

    q, k, v = project(p_lat)
    qc, kc, vc = project(p_ctx)
    scale = MLA_QK_DIM ** -0.5
    o = joint_attention(rope_tail(q), q, rope_tail(k), v, kc, vc, scale)
    o_lat = o.reshape(p_lat.shape[0], p_lat.shape[1], BRANCH_WIDTH)
    o_ctx = None
    if need_ctx:
        o_ctx = ctx_attention(qc, kc, vc, scale).reshape(p_ctx.shape[0], p_ctx.shape[1], BRANCH_WIDTH)
    return o_lat, o_ctx


def merge_branches(n, outs, w_gate, b_gate, w_branch, w_out):
    y = jax.nn.sigmoid(n @ w_gate[0] + b_gate[0]) * (outs[0] @ w_branch[0])
    for j in range(1, N_BRANCH):
        y = y + jax.nn.sigmoid(n @ w_gate[j] + b_gate[j]) * (outs[j] @ w_branch[j])
    return y @ w_out


def setup_inputs(seed: int = 0) -> dict:
    key = jax.random.key(seed)
    keys = iter(jax.random.split(key, 32))
    f32 = jnp.float32

    def normal(shape, std):
        return jax.random.normal(next(keys), shape, f32) * std

    def gain(shape):
        return 1.0 + normal(shape, 0.05)

    L, D = DEPTH, D_MODEL
    return {
        'x': normal((BATCH, SEQ, D), 1.0),
        'c': normal((BATCH, D), 1.0),
        'ctx': normal((BATCH, CTX_LEN, D), 1.0),
        'c_ctx': normal((D,), 1.0),
        'w_ada': normal((L, D, N_MOD * D), 0.5 * D ** -0.5),
        'b_ada': normal((L, N_MOD * D), 0.02),
        'norm_g': gain((L, 3, D)),
        'ffn_w1': normal((L, 2, D, D_FF), D ** -0.5),
        'ffn_w3': normal((L, 2, D, D_FF), D ** -0.5),
        'ffn_w2': normal((L, 2, D_FF, D), D_FF ** -0.5),
        'w_in': normal((L, D, IN_COLS), D ** -0.5),
        'na_g_q': gain((L, HEAD_DIM)),
        'na_g_k': gain((L, HEAD_DIM)),
        'na_rpb': normal((L, BRANCH_HEADS, 2 * NA_WIN_H - 1, 2 * NA_WIN_W - 1), 0.1),
        'gqa_g_q': gain((L, HEAD_DIM)),
        'gqa_g_k': gain((L, HEAD_DIM)),
        'diff_g_q': gain((L, DIFF_QK_DIM)),
        'diff_g_k': gain((L, DIFF_QK_DIM)),
        'diff_lambda': normal((L, 4, DIFF_QK_DIM), 0.1),
        'diff_g_sub': gain((L, HEAD_DIM)),
        'mla_g_cq': gain((L, MLA_Q_RANK)),
        'mla_g_ckv': gain((L, MLA_KV_RANK)),
        'mla_w_uq': normal((L, MLA_Q_RANK, BRANCH_HEADS * MLA_QK_DIM), MLA_Q_RANK ** -0.5),
        'mla_w_ukv': normal((L, MLA_KV_RANK, BRANCH_HEADS * (MLA_NOPE_DIM + HEAD_DIM)), MLA_KV_RANK ** -0.5),
        'mla_g_q': gain((L, MLA_QK_DIM)),
        'mla_g_k': gain((L, MLA_QK_DIM)),
        'w_gate': normal((L, N_BRANCH, D, D), D ** -0.5),
        'b_gate': normal((L, N_BRANCH, D), 0.02),
        'w_branch': normal((L, N_BRANCH, BRANCH_WIDTH, D), BRANCH_WIDTH ** -0.5),
        'w_out': normal((L, D, D), D ** -0.5),
    }


def reference(x, c, ctx, c_ctx, w_ada, b_ada, norm_g, ffn_w1, ffn_w3, ffn_w2, w_in,
              na_g_q, na_g_k, na_rpb, gqa_g_q, gqa_g_k, diff_g_q, diff_g_k, diff_lambda, diff_g_sub,
              mla_g_cq, mla_g_ckv, mla_w_uq, mla_w_ukv, mla_g_q, mla_g_k,
              w_gate, b_gate, w_branch, w_out):
    S = x.shape[1]
    cos64, sin64 = axial_rope_tables(S, HEAD_DIM)
    cos_d, sin_d = axial_rope_tables(S, DIFF_QK_DIM)
    cos_m, sin_m = axial_rope_tables(S, MLA_ROPE_DIM)
    silu_c = jax.nn.silu(c)
    silu_cc = jax.nn.silu(c_ctx)[None, :]
    xl, xc = x, ctx
    for i in range(DEPTH):
        need_ctx = i < DEPTH - 1
        mod_l = jnp.split(silu_c @ w_ada[i] + b_ada[i], N_MOD, axis=-1)
        mod_c = jnp.split(silu_cc @ w_ada[i] + b_ada[i], N_MOD, axis=-1)
        xl = ffn_half_step(xl, norm_g[i, 0], mod_l[0], mod_l[1], mod_l[2], ffn_w1[i, 0], ffn_w3[i, 0], ffn_w2[i, 0])
        xc = ffn_half_step(xc, norm_g[i, 0], mod_c[0], mod_c[1], mod_c[2], ffn_w1[i, 0], ffn_w3[i, 0], ffn_w2[i, 0])
        nl = modulate(xl, norm_g[i, 1], mod_l[3], mod_l[4])
        nc = modulate(xc, norm_g[i, 1], mod_c[3], mod_c[4])
        pl = jnp.split(nl @ w_in[i], IN_SPLITS, axis=-1)
        pc = jnp.split(nc @ w_in[i], IN_SPLITS, axis=-1)
        lam_init = 0.8 - 0.6 * math.exp(-0.3 * i)
        outs = [
            mixer_na(pl[0], pc[0], na_g_q[i], na_g_k[i], na_rpb[i], need_ctx),
            mixer_gqa(pl[1], pc[1], gqa_g_q[i], gqa_g_k[i], cos64, sin64, need_ctx),
            mixer_diff(pl[2], pc[2], diff_g_q[i], diff_g_k[i], diff_lambda[i], diff_g_sub[i], lam_init,
                       cos_d, sin_d, need_ctx),
            mixer_mla(pl[3], pc[3], mla_g_cq[i], mla_g_ckv[i], mla_w_uq[i], mla_w_ukv[i], mla_g_q[i], mla_g_k[i],
                      cos_m, sin_m, need_ctx),
        ]
        xl = xl + mod_l[5][:, None, :] * merge_branches(nl, [o[0] for o in outs], w_gate[i], b_gate[i], w_branch[i], w_out[i])
        if need_ctx:
            xc = xc + mod_c[5][:, None, :] * merge_branches(nc, [o[1] for o in outs], w_gate[i], b_gate[i], w_branch[i], w_out[i])
            xc = ffn_half_step(xc, norm_g[i, 2], mod_c[6], mod_c[7], mod_c[8], ffn_w1[i, 1], ffn_w3[i, 1], ffn_w2[i, 1])
        xl = ffn_half_step(xl, norm_g[i, 2], mod_l[6], mod_l[7], mod_l[8], ffn_w1[i, 1], ffn_w3[i, 1], ffn_w2[i, 1])
    return xl
```

```cpp
#include <hip/hip_runtime.h>
#include <hip/hip_cooperative_groups.h>
#include <cstdio>
#include <cstdint>
namespace cg = cooperative_groups;

typedef unsigned short bf16_t;
typedef short bf16x8 __attribute__((ext_vector_type(8)));
typedef float f32x4 __attribute__((ext_vector_type(4)));
typedef float f32x16 __attribute__((ext_vector_type(16)));
typedef __bf16 bf2_t __attribute__((ext_vector_type(2)));
typedef float f2_t __attribute__((ext_vector_type(2)));
typedef unsigned u32x4 __attribute__((ext_vector_type(4)));
typedef unsigned u32x2 __attribute__((ext_vector_type(2)));
#define DI __device__ __forceinline__

constexpr int D = 1024, NB = 8, S = 4096, CL = 256, DEPTH = 4, DFF = 2816, INC = 2464, INCP = 2560;
constexpr int ML = NB * S, MC = NB * CL, MT = ML + MC, KEYS = S + CL;
constexpr float LOG2E = 1.4426950408889634f;
constexpr float EPS = 1e-6f;

constexpr size_t al256(size_t x) { return (x + 255) & ~(size_t)255; }
constexpr size_t OFF_XC = 0;
constexpr size_t OFF_MOD = OFF_XC + (size_t)MC * D * 4;
constexpr size_t OFF_CTRL = OFF_MOD + al256((size_t)DEPTH * 9 * 9216 * 4);
constexpr size_t OFF_H = OFF_CTRL + 4096;
constexpr size_t OFF_W13A = OFF_H + (size_t)MT * D * 2;
constexpr size_t OFF_W2A = OFF_W13A + (size_t)2 * DFF * D * 2;
constexpr size_t OFF_W13B = OFF_W2A + (size_t)D * DFF * 2;
constexpr size_t OFF_W2B = OFF_W13B + (size_t)2 * DFF * D * 2;
constexpr size_t OFF_WIN = OFF_W2B + (size_t)D * DFF * 2;
constexpr size_t OFF_WG = OFF_WIN + (size_t)INCP * D * 2;
constexpr size_t OFF_WB = OFF_WG + (size_t)4 * D * D * 2;
constexpr size_t OFF_WO = OFF_WB + (size_t)4 * D * 256 * 2;
constexpr size_t OFF_WUQ = OFF_WO + (size_t)D * D * 2;
constexpr size_t OFF_WUKV = OFF_WUQ + (size_t)384 * 256 * 2;
constexpr size_t OFF_BIG = OFF_WUKV + (size_t)512 * 128 * 2;
constexpr size_t OFF_Y = OFF_BIG + (size_t)MT * D * 2;
constexpr size_t OFF_QKV = OFF_BIG + (size_t)MT * DFF * 2;
constexpr size_t N_Q64K = (size_t)NB * 4 * KEYS * 64;
constexpr size_t N_Q64S = (size_t)NB * 4 * S * 64;
constexpr size_t OFF_NA_Q = OFF_QKV;
constexpr size_t OFF_NA_K = OFF_NA_Q + N_Q64K * 2;
constexpr size_t OFF_NA_VT = OFF_NA_K + N_Q64K * 2;
constexpr size_t OFF_G_QP = OFF_NA_VT + N_Q64K * 2;
constexpr size_t OFF_G_QN = OFF_G_QP + N_Q64S * 2;
constexpr size_t OFF_G_K = OFF_G_QN + N_Q64K * 2;
constexpr size_t OFF_G_VT = OFF_G_K + (size_t)NB * 2 * KEYS * 64 * 2;
constexpr size_t OFF_D_QP = OFF_G_VT + (size_t)NB * 2 * KEYS * 64 * 2;
constexpr size_t OFF_D_QN = OFF_D_QP + (size_t)NB * 8 * S * 32 * 2;
constexpr size_t OFF_D_K = OFF_D_QN + (size_t)NB * 8 * KEYS * 32 * 2;
constexpr size_t OFF_D_VT = OFF_D_K + (size_t)NB * 8 * KEYS * 32 * 2;
constexpr size_t OFF_M_QP = OFF_D_VT + N_Q64K * 2;
constexpr size_t OFF_M_QN = OFF_M_QP + (size_t)NB * 4 * S * 96 * 2;
constexpr size_t OFF_M_K = OFF_M_QN + (size_t)NB * 4 * KEYS * 96 * 2;
constexpr size_t OFF_M_VT = OFF_M_K + (size_t)NB * 4 * KEYS * 96 * 2;
constexpr size_t OFF_SCR = OFF_M_VT + N_Q64K * 2;
constexpr size_t OFF_BAR = OFF_SCR + (size_t)1024 * 8192 * 4;
constexpr size_t WS_NEED = OFF_BAR + 16384;

constexpr int LDS_BYTES = 131072;
constexpr int NTHR = 512, NWAVE = 8;

struct Params {
  const float* in[30];
  float* out;
  unsigned char* ws;
};
typedef const __attribute__((address_space(4))) Params& PR;
typedef const __attribute__((address_space(4))) Params* KP;

DI int tid() { int t = __builtin_amdgcn_workitem_id_x(); asm volatile("" : "+v"(t)); return t; }
DI float bf2f(bf16_t v) { return __uint_as_float(((unsigned)v) << 16); }
DI unsigned pk(float a, float b) { f2_t v = {a, b}; bf2_t r = __builtin_convertvector(v, bf2_t); return __builtin_bit_cast(unsigned, r); }
DI bf16_t f2bf(float a) { return (bf16_t)(pk(a, 0.f) & 0xffffu); }
DI float shx(float v, int mask) { return __int_as_float(__builtin_amdgcn_ds_bpermute(((tid() ^ mask) & 63) << 2, __float_as_int(v))); }
template <int CTRL> DI float dppf(float v) { return __int_as_float(__builtin_amdgcn_update_dpp(0, __float_as_int(v), CTRL, 0xF, 0xF, true)); }
DI float sum4(float v)  { v += dppf<0xB1>(v); v += dppf<0x4E>(v); return v; }
DI float sum8(float v)  { v = sum4(v); v += dppf<0x141>(v); return v; }
DI float sum16(float v) { v = sum8(v); v += dppf<0x140>(v); return v; }
DI float wsum64(float v) {
  v = sum16(v); v += shx(v, 16); v += shx(v, 32);
  return v;
}
DI float wsum32(float v) {
  v += shx(v, 16); v += shx(v, 8); v += shx(v, 4); v += shx(v, 2); v += shx(v, 1);
  return v;
}
DI float* xrow(PR p, int m) {
  return m < ML ? p.out + (size_t)m * D : (float*)(p.ws + OFF_XC) + (size_t)(m - ML) * D;
}
DI const float* xsrc(PR p, int m, bool first) {
  if (!first) return xrow(p, m);
  return m < ML ? p.in[0] + (size_t)m * D : p.in[2] + (size_t)(m - ML) * D;
}
DI const float* modrow(PR p, int layer, int m) {
  const int b = m < ML ? (m >> 12) : 8;
  return (const float*)(p.ws + OFF_MOD) + (size_t)(layer * 9 + b) * 9216;
}

DI int rowmap(int n, int mode) { return mode == 0 ? n : ((n >> 4) * 32 + (n & 15) + (mode == 2 ? 16 : 0)); }
DI void conv_job(const float* __restrict__ src, int K, int N, bf16_t* __restrict__ dst, int mode, unsigned char* smem, int rot) {
  const int tn = (N + 63) >> 6, ntile = (K >> 6) * tn, npair = (ntile + 1) >> 1;
  const int tf = tid(), half = tf >> 8, t = tf & 255;
  bf16_t* tl = (bf16_t*)smem + half * (64 * 66);
  const int G = gridDim.x;
  int start = (int)((blockIdx.x + G - (rot % G)) % G);
  for (int pu = start; pu < npair; pu += G) {
    const int u = pu * 2 + half;
    const bool act = u < ntile;
    const int k0 = (u / tn) << 6, n0 = (u % tn) << 6;
    __syncthreads();
    if (act) {
#pragma unroll
      for (int i = 0; i < 4; ++i) {
        const int kk = (t >> 4) + 16 * i, nn = (t & 15) * 4;
        if (n0 + nn < N) {
          const float4 v = *(const float4*)(src + (size_t)(k0 + kk) * N + n0 + nn);
          tl[(nn + 0) * 66 + kk] = f2bf(v.x); tl[(nn + 1) * 66 + kk] = f2bf(v.y);
          tl[(nn + 2) * 66 + kk] = f2bf(v.z); tl[(nn + 3) * 66 + kk] = f2bf(v.w);
        }
      }
    }
    __syncthreads();
    const int nl = t >> 2, part = t & 3, n = n0 + nl;
    if (act && n < N) {
      const unsigned* s32 = (const unsigned*)(tl + nl * 66 + part * 16);
      uint4 a, b;
      a.x = s32[0]; a.y = s32[1]; a.z = s32[2]; a.w = s32[3]; b.x = s32[4]; b.y = s32[5]; b.z = s32[6]; b.w = s32[7];
      uint4* d = (uint4*)(dst + (size_t)rowmap(n, mode) * K + k0 + part * 16);
      d[0] = a; d[1] = b;
    }
  }
}
DI void conv_ffn(PR p, int layer, int which, unsigned char* smem) {
  const size_t o = (size_t)(layer * 2 + which) * D * DFF;
  bf16_t* w13 = (bf16_t*)(p.ws + (which ? OFF_W13B : OFF_W13A));
  bf16_t* w2 = (bf16_t*)(p.ws + (which ? OFF_W2B : OFF_W2A));
  conv_job(p.in[7] + o, D, DFF, w13, 1, smem, 0);
  conv_job(p.in[8] + o, D, DFF, w13, 2, smem, 96);
  conv_job(p.in[9] + o, DFF, D, w2, 0, smem, 192);
}
DI void conv_mixer(PR p, int layer, unsigned char* smem) {
  conv_job(p.in[10] + (size_t)layer * D * INC, D, INC, (bf16_t*)(p.ws + OFF_WIN), 0, smem, 0);
  for (int j = 0; j < 4; ++j)
    conv_job(p.in[26] + (size_t)(layer * 4 + j) * D * D, D, D, (bf16_t*)(p.ws + OFF_WG) + (size_t)j * D * D, 0, smem, 20 + 64 * j);
  for (int j = 0; j < 4; ++j)
    conv_job(p.in[28] + (size_t)(layer * 4 + j) * 256 * D, 256, D, (bf16_t*)(p.ws + OFF_WB) + (size_t)j * D * 256, 0, smem, 20 + 32 * j);
  conv_job(p.in[29] + (size_t)layer * D * D, D, D, (bf16_t*)(p.ws + OFF_WO), 0, smem, 148);
  conv_job(p.in[22] + (size_t)layer * 256 * 384, 256, 384, (bf16_t*)(p.ws + OFF_WUQ), 0, smem, 212);
  conv_job(p.in[23] + (size_t)layer * 128 * 512, 128, 512, (bf16_t*)(p.ws + OFF_WUKV), 0, smem, 224);
}

DI void phase_prologue(PR p, unsigned char* smem) {
  const int t = tid(), lane = t & 63, wave = t >> 6;
  if (blockIdx.x == 0 && t < 256) ((int*)(p.ws + OFF_CTRL))[t] = 0;
  float* sl = (float*)smem;
  float* red = sl + 9 * 1024;
  for (int i = t; i < 9 * 1024; i += NTHR) {
    const int r = i >> 10, k = i & 1023;
    const float v = r < 8 ? p.in[1][r * 1024 + k] : p.in[3][k];
    sl[i] = v / (1.f + __expf(-v));
  }
  __syncthreads();
  for (int u = blockIdx.x; u < DEPTH * 144; u += gridDim.x) {
    const int l = u / 144, n0 = (u % 144) * 64;
    const float* w = p.in[4] + (size_t)l * 1024 * 9216 + n0 + lane;
    float acc[9];
#pragma unroll
    for (int r = 0; r < 9; ++r) acc[r] = 0.f;
    const int kb = wave * 128;
#pragma unroll 16
    for (int k = kb; k < kb + 128; ++k) {
      const float wv = w[(size_t)k * 9216];
#pragma unroll
      for (int r = 0; r < 9; ++r) acc[r] += sl[r * 1024 + k] * wv;
    }
#pragma unroll
    for (int r = 0; r < 9; ++r) red[(wave * 9 + r) * 64 + lane] = acc[r];
    __syncthreads();
    for (int i = t; i < 9 * 64; i += NTHR) {
      const int r = i >> 6, c = i & 63;
      float sum = 0.f;
#pragma unroll
      for (int w = 0; w < NWAVE; ++w) sum += red[(w * 9 + r) * 64 + c];
      ((float*)(p.ws + OFF_MOD))[(size_t)(l * 9 + r) * 9216 + n0 + c] = sum + p.in[5][l * 9216 + n0 + c];
    }
    __syncthreads();
  }
  conv_ffn(p, 0, 0, smem);
  conv_ffn(p, 0, 1, smem);
  conv_mixer(p, 0, smem);
}

DI void phase_norm(PR p, int layer, int which, int shift_idx, int scale_idx, int mrows, bool first = false) {
  const int lane = tid() & 63, wave = tid() >> 6;
  const float* g = p.in[6] + (size_t)(layer * 3 + which) * D;
  bf16_t* H = (bf16_t*)(p.ws + OFF_H);
  const int stride = gridDim.x * NWAVE;
  int row = blockIdx.x * NWAVE + wave;
  float4 v[4], nv[4];
  if (row < mrows) {
    const float4* xr = (const float4*)xsrc(p, row, first);
#pragma unroll
    for (int i = 0; i < 4; ++i) v[i] = xr[lane + 64 * i];
  }
  for (; row < mrows; row += stride) {
    const int nrow = row + stride;
    if (nrow < mrows) {
      const float4* xr = (const float4*)xsrc(p, nrow, first);
#pragma unroll
      for (int i = 0; i < 4; ++i) nv[i] = xr[lane + 64 * i];
    }
    const float* mod = modrow(p, layer, row);
    float ss = 0.f;
#pragma unroll
    for (int i = 0; i < 4; ++i) ss += v[i].x * v[i].x + v[i].y * v[i].y + v[i].z * v[i].z + v[i].w * v[i].w;
    ss = wsum64(ss);
    const float rstd = rsqrtf(ss * (1.f / 1024.f) + EPS);
#pragma unroll
    for (int i = 0; i < 4; ++i) {
      const int c = 4 * (lane + 64 * i);
      const float4 g4 = *(const float4*)(g + c), sc = *(const float4*)(mod + scale_idx * 1024 + c), sh = *(const float4*)(mod + shift_idx * 1024 + c);
      const float h0 = v[i].x * rstd * g4.x * (1.f + sc.x) + sh.x, h1 = v[i].y * rstd * g4.y * (1.f + sc.y) + sh.y;
      const float h2 = v[i].z * rstd * g4.z * (1.f + sc.z) + sh.z, h3 = v[i].w * rstd * g4.w * (1.f + sc.w) + sh.w;
      uint2 o; o.x = pk(h0, h1); o.y = pk(h2, h3);
      *(uint2*)(H + (size_t)row * D + c) = o;
    }
#pragma unroll
    for (int i = 0; i < 4; ++i) v[i] = nv[i];
  }
}

DI int lds_byte(int r, int c) {
  const int st = (r >> 4) * 2 + (c >> 5), ob = (r & 15) * 64 + (c & 31) * 2;
  return st * 1024 + (ob ^ (((ob >> 9) & 1) << 5));
}
DI void stage_rc(int b, int& R, int& C) {
  const int st = b >> 10, sb = b & 1023, swz = sb ^ (((sb >> 9) & 1) << 5);
  R = (st >> 1) * 16 + swz / 64;
  C = (st & 1) * 32 + (swz % 64) / 2;
}
#define WAIT_V0() asm volatile("s_waitcnt vmcnt(0)" ::: "memory")
constexpr int G_STAGE = 65536;

struct GSeg { const bf16_t* A; const bf16_t* Bt; int lda, ldb, nk, m0, n0; };
constexpr int PFD = 100000;
#define WAIT_V1() asm volatile("s_waitcnt vmcnt(1)" ::: "memory")

template <int MTW, int NTW = 4>
DI void gemm_mainloop(const GSeg& sg, const GSeg& nx, unsigned char* smem, f32x4 (&acc)[MTW][NTW]) {
  constexpr int GLA = MTW / 2, GLB = NTW;
  const int t = tid(), lane = t & 63, wid = t >> 6, wr = wid >> 2, wc = wid & 3, fr = lane & 15, fq = lane >> 4;
  const bf16_t* ga[GLA]; const bf16_t* gb[GLB];
#pragma unroll
  for (int i = 0; i < GLA; ++i) { int R, C; stage_rc(wid * 1024 + i * 8192 + lane * 16, R, C); ga[i] = sg.A + (size_t)(sg.m0 + R) * sg.lda + C; }
#pragma unroll
  for (int i = 0; i < GLB; ++i) { int R, C; stage_rc(wid * 1024 + i * 8192 + lane * 16, R, C); gb[i] = sg.Bt + (size_t)(sg.n0 + R) * sg.ldb + C; }
  const int prow = t < 256 ? min(t, MTW * 32 - 1) : t - 256;
  const bf16_t* pf_c = t < 256 ? sg.A + (size_t)(sg.m0 + prow) * sg.lda : sg.Bt + (size_t)(sg.n0 + prow) * sg.ldb;
  const bf16_t* pf_n = t < 256 ? nx.A + (size_t)(nx.m0 + prow) * nx.lda : nx.Bt + (size_t)(nx.n0 + prow) * nx.ldb;
  unsigned pfd = 0u;
#define G_STAGE_IN(buf, kt)                                                                                          \
  {                                                                                                                  \
    _Pragma("unroll") for (int i = 0; i < GLA; ++i)                                                                  \
      __builtin_amdgcn_global_load_lds((const unsigned*)(ga[i] + (kt) * 64), (unsigned*)(smem + (buf) * G_STAGE + wid * 1024 + i * 8192), 16, 0, 0); \
    _Pragma("unroll") for (int i = 0; i < GLB; ++i)                                                                  \
      __builtin_amdgcn_global_load_lds((const unsigned*)(gb[i] + (kt) * 64), (unsigned*)(smem + (buf) * G_STAGE + 32768 + wid * 1024 + i * 8192), 16, 0, 0); \
  }
  const int nk = sg.nk;
  G_STAGE_IN(0, 0);
  WAIT_V0();
  __syncthreads();
  if (nk > 1) G_STAGE_IN(1, 1);
#pragma unroll 1
  for (int kt = 0; kt < nk; ++kt) {
    const int cur = kt & 1;
    const int pj = kt + PFD;
    const bool pf_on = pj < nk || (pj - nk) < nx.nk;
    if (pf_on) {
      const bf16_t* pa = pj < nk ? pf_c + pj * 64 : pf_n + (pj - nk) * 64;
      asm volatile("global_load_dword %0, %1, off" : "+v"(pfd) : "v"(pa) : "memory");
    }
    const unsigned char* sa = smem + cur * G_STAGE;
    const unsigned char* sb = sa + 32768;
    bf16x8 At[MTW], Bf[NTW];
#pragma unroll
    for (int m = 0; m < MTW; ++m) At[m] = *(const bf16x8*)(sa + lds_byte(wr * (MTW * 16) + m * 16 + fr, fq * 8));
#pragma unroll
    for (int n = 0; n < NTW; ++n) Bf[n] = *(const bf16x8*)(sb + lds_byte(wc * (NTW * 16) + n * 16 + fr, fq * 8));
#pragma unroll
    for (int m = 0; m < MTW; ++m)
#pragma unroll
      for (int n = 0; n < NTW; ++n) acc[m][n] = __builtin_amdgcn_mfma_f32_16x16x32_bf16(Bf[n], At[m], acc[m][n], 0, 0, 0);
    bf16x8 At1[MTW], Bf1[NTW];
#pragma unroll
    for (int m = 0; m < MTW; ++m) At1[m] = *(const bf16x8*)(sa + lds_byte(wr * (MTW * 16) + m * 16 + fr, 32 + fq * 8));
#pragma unroll
    for (int n = 0; n < NTW; ++n) Bf1[n] = *(const bf16x8*)(sb + lds_byte(wc * (NTW * 16) + n * 16 + fr, 32 + fq * 8));
    if (pf_on) { WAIT_V1(); } else { WAIT_V0(); }
    __syncthreads();
    if (kt + 2 < nk) G_STAGE_IN(cur, kt + 2);
    __builtin_amdgcn_sched_barrier(0);
#pragma unroll
    for (int m = 0; m < MTW; ++m)
#pragma unroll
      for (int n = 0; n < NTW; ++n) acc[m][n] = __builtin_amdgcn_mfma_f32_16x16x32_bf16(Bf1[n], At1[m], acc[m][n], 0, 0, 0);
  }
  WAIT_V0();
  asm volatile("" :: "v"(pfd));
#undef G_STAGE_IN
}

#define PG8_LAS __attribute__((address_space(3)))
struct PG8Unit { int pm, pn; };
struct PG8Gemm { const bf16_t* A; const bf16_t* Bt; int lda, ldb, K; };
struct PG8Order {
  int ntiles, chunk, xcd, li, per, pm0;
  DI void init(int pm0_, int mtiles, int ntiles_) { pm0 = pm0_; ntiles = ntiles_; chunk = (mtiles * ntiles_) >> 3; xcd = blockIdx.x & 7; li = blockIdx.x >> 3; per = gridDim.x >> 3; }
  DI bool next(int i, PG8Unit& u) const {
    const int q = li + i * per; if (q >= chunk) return false;
    const int T = xcd * chunk + q, mg = T / (4 * ntiles), rem = T % (4 * ntiles);
    u.pm = pm0 + mg * 4 + (rem & 3); u.pn = rem >> 2; return true;
  }
};
#define Unit PG8Unit
template <class Epi, class Sched>
__device__ __forceinline__ void pg8_gemm_phase(PG8_LAS unsigned char* lds, const PG8Gemm g, const Sched& S, const Epi& E) {
    constexpr bool ALIGN_EPI = true, SP2 = true;
    constexpr int BK = 64, HALF = 128, HTB = HALF * BK * 2;
    const int tid = ::tid(), wid = __builtin_amdgcn_readfirstlane(tid >> 6), lane = tid & 63, wr = wid >> 2, wc = wid & 3, fr = lane & 15, fq = lane >> 4;
    const int K = g.K, nt = K / BK;
    unsigned voffA[2], voffB[2];
#pragma unroll
    for (int i = 0; i < 2; ++i) { int R, C; stage_rc(tid * 16 + i * 8192, R, C); const int Rb = R;
        voffA[i] = (unsigned)(R * g.lda + C) * 2u; voffB[i] = (unsigned)(Rb * g.ldb + C) * 2u; }
    const size_t kstep = (size_t)(BK * 2);
    const size_t hstepA = (size_t)HALF * g.lda * 2, hstepB = (size_t)HALF * g.ldb * 2;
    const size_t tstepA = 2 * hstepA, tstepB = 2 * hstepB;
    const unsigned ldsw = (unsigned)wid * 1024u;
    const int aoff = lds_byte(wr * 64 + fr, fq * 8), boff = lds_byte(wc * 32 + fr, fq * 8);
#define PG8_SA(b, h) (((b) * 2 + (h)) * HTB)
#define PG8_SB(b, h) ((4 + (b) * 2 + (h)) * HTB)
#define PG8_STAGE(bufoff, gbase, voff) do { _Pragma("unroll") for (int _i = 0; _i < 2; ++_i) \
        __builtin_amdgcn_global_load_lds((const unsigned*)((const char*)(gbase) + (voff)[_i]), (PG8_LAS unsigned*)(lds + (bufoff) + ldsw + _i * 8192), 16, 0, 0); } while (0)
#define PG8_LDA(dst, b, h) do { _Pragma("unroll") for (int m = 0; m < 4; ++m) _Pragma("unroll") for (int k = 0; k < 2; ++k) dst[m][k] = *(const PG8_LAS bf16x8*)(lds + PG8_SA(b, h) + aoff + m * 2048 + k * 1024); } while (0)
#define PG8_LDB(dst, b, h) do { _Pragma("unroll") for (int n = 0; n < 2; ++n) _Pragma("unroll") for (int k = 0; k < 2; ++k) dst[n][k] = *(const PG8_LAS bf16x8*)(lds + PG8_SB(b, h) + boff + n * 2048 + k * 1024); } while (0)
#define PG8_MMA(ai, bj, At, Bt) do { __builtin_amdgcn_s_setprio(1); _Pragma("unroll") for (int m = 0; m < 4; ++m) _Pragma("unroll") for (int n = 0; n < 2; ++n) _Pragma("unroll") for (int k = 0; k < 2; ++k) \
        acc[ai][bj][m][n] = __builtin_amdgcn_mfma_f32_16x16x32_bf16(Bt[n][k], At[m][k], acc[ai][bj][m][n], 0, 0, 0); __builtin_amdgcn_s_setprio(0); } while (0)
#define PG8_WAIT_V(n) asm volatile("s_waitcnt vmcnt(" #n ")" ::: "memory")
#define PG8_WAIT_L(n) asm volatile("s_waitcnt lgkmcnt(" #n ")" ::: "memory")
#define PG8_BAR __builtin_amdgcn_s_barrier()
#define PG8_SCHED __builtin_amdgcn_sched_barrier(0)
    Unit cur, nxt; int ui = 0;
    if (!S.next(0, cur)) return;
    f32x4 acc[2][2][4][2];
#pragma unroll
    for (int a = 0; a < 2; ++a)
#pragma unroll
        for (int b = 0; b < 2; ++b)
#pragma unroll
            for (int m = 0; m < 4; ++m)
#pragma unroll
                for (int n = 0; n < 2; ++n) acc[a][b][m][n] = (f32x4){0.f, 0.f, 0.f, 0.f};
    bf16x8 At[4][2], B0[2][2], B1[2][2];
    const char* cA = (const char*)g.A + (size_t)cur.pm * tstepA; const char* cB = (const char*)g.Bt + (size_t)cur.pn * tstepB;
    if constexpr (SP2) {
        PG8_STAGE(PG8_SB(0, 0), cB, voffB); PG8_STAGE(PG8_SB(0, 1), cB + hstepB, voffB); PG8_STAGE(PG8_SA(0, 0), cA, voffA); PG8_STAGE(PG8_SA(0, 1), cA + hstepA, voffA);
        if (wr == 1) PG8_BAR;
        PG8_WAIT_V(2); PG8_BAR;
        PG8_STAGE(PG8_SB(1, 0), cB + kstep, voffB); PG8_STAGE(PG8_SA(1, 0), cA + kstep, voffA); PG8_STAGE(PG8_SB(1, 1), cB + hstepB + kstep, voffB);
        PG8_WAIT_V(6); PG8_BAR;
    } else {
        PG8_STAGE(PG8_SB(0, 0), cB, voffB); PG8_STAGE(PG8_SA(0, 0), cA, voffA); PG8_STAGE(PG8_SB(0, 1), cB + hstepB, voffB); PG8_STAGE(PG8_SA(0, 1), cA + hstepA, voffA);
        if (wr == 1) PG8_BAR;
        PG8_WAIT_V(4); PG8_BAR;
        PG8_STAGE(PG8_SB(1, 0), cB + kstep, voffB); PG8_STAGE(PG8_SA(1, 0), cA + kstep, voffA); PG8_STAGE(PG8_SB(1, 1), cB + hstepB + kstep, voffB);
        PG8_WAIT_V(6); PG8_BAR;
    }
    for (;;) {
        const bool has_next = S.next(ui + 1, nxt);
        const char* nA = has_next ? (const char*)g.A + (size_t)nxt.pm * tstepA : cA; const char* nB = has_next ? (const char*)g.Bt + (size_t)nxt.pn * tstepB : cB;
        for (int t = 0; t < nt; t += 2) {
            const bool last = (t == nt - 2);
            const char* a1 = cA + (size_t)(t + 1) * kstep;
            const char* a2 = last ? nA : cA + (size_t)(t + 2) * kstep; const char* b2 = last ? nB : cB + (size_t)(t + 2) * kstep;
            const char* a3 = a2 + kstep; const char* b3 = b2 + kstep;

            if constexpr (SP2) {
            PG8_LDB(B0, 0, 0); PG8_LDB(B1, 0, 1); PG8_SCHED; PG8_LDA(At, 0, 0); PG8_STAGE(PG8_SA(1, 1), a1 + hstepA, voffA);
            PG8_WAIT_V(8); PG8_WAIT_L(0); PG8_BAR; PG8_MMA(0, 0, At, B0); PG8_MMA(0, 1, At, B1); PG8_BAR; PG8_SCHED;
            PG8_LDA(At, 0, 1); PG8_STAGE(PG8_SB(0, 0), b2, voffB); PG8_STAGE(PG8_SB(0, 1), b2 + hstepB, voffB); PG8_STAGE(PG8_SA(0, 0), a2, voffA);
            PG8_WAIT_V(8); PG8_WAIT_L(0); PG8_BAR; PG8_MMA(1, 0, At, B0); PG8_MMA(1, 1, At, B1); PG8_BAR; PG8_SCHED;
            PG8_LDB(B0, 1, 0); PG8_LDB(B1, 1, 1); PG8_SCHED; PG8_LDA(At, 1, 0); PG8_STAGE(PG8_SA(0, 1), a2 + hstepA, voffA);
            PG8_WAIT_V(8); PG8_WAIT_L(0); PG8_BAR; PG8_MMA(0, 0, At, B0); PG8_MMA(0, 1, At, B1); PG8_BAR; PG8_SCHED;
            PG8_LDA(At, 1, 1); PG8_STAGE(PG8_SB(1, 0), b3, voffB); PG8_STAGE(PG8_SB(1, 1), b3 + hstepB, voffB); PG8_STAGE(PG8_SA(1, 0), a3, voffA);
            PG8_WAIT_V(8); PG8_WAIT_L(0); PG8_BAR; PG8_MMA(1, 0, At, B0); PG8_MMA(1, 1, At, B1); PG8_BAR; PG8_SCHED;
            } else {
            PG8_LDB(B0, 0, 0); PG8_SCHED; PG8_LDA(At, 0, 0); PG8_STAGE(PG8_SA(1, 1), a1 + hstepA, voffA);
            PG8_WAIT_L(8); PG8_BAR; PG8_WAIT_L(0); PG8_MMA(0, 0, At, B0); PG8_BAR; PG8_SCHED;
            PG8_LDB(B1, 0, 1); PG8_STAGE(PG8_SB(0, 0), b2, voffB);
            PG8_BAR; PG8_WAIT_L(0); PG8_MMA(0, 1, At, B1); PG8_BAR;
            PG8_LDA(At, 0, 1); PG8_STAGE(PG8_SA(0, 0), a2, voffA);
            PG8_BAR; PG8_WAIT_L(0); PG8_MMA(1, 0, At, B0); PG8_BAR; PG8_SCHED;
            PG8_STAGE(PG8_SB(0, 1), b2 + hstepB, voffB);
            PG8_WAIT_V(6); PG8_BAR; PG8_MMA(1, 1, At, B1); PG8_BAR;
            PG8_LDB(B0, 1, 0); PG8_SCHED; PG8_LDA(At, 1, 0); PG8_STAGE(PG8_SA(0, 1), a2 + hstepA, voffA);
            PG8_WAIT_L(8); PG8_BAR; PG8_WAIT_L(0); PG8_MMA(0, 0, At, B0); PG8_BAR; PG8_SCHED;
            PG8_LDB(B1, 1, 1); PG8_STAGE(PG8_SB(1, 0), b3, voffB);
            PG8_BAR; PG8_WAIT_L(0); PG8_MMA(0, 1, At, B1); PG8_BAR;
            PG8_LDA(At, 1, 1); PG8_STAGE(PG8_SA(1, 0), a3, voffA);
            PG8_BAR; PG8_WAIT_L(0); PG8_MMA(1, 0, At, B0); PG8_BAR; PG8_SCHED;
            PG8_STAGE(PG8_SB(1, 1), b3 + hstepB, voffB);
            PG8_WAIT_V(6); PG8_BAR; PG8_MMA(1, 1, At, B1); PG8_BAR;
            }
        }
        if constexpr (ALIGN_EPI) { if (wr == 0) PG8_BAR; }
        E(acc, cur, wr, wc, fr, fq);
        if (!has_next) break;
#pragma unroll
        for (int a = 0; a < 2; ++a)
#pragma unroll
            for (int b = 0; b < 2; ++b)
#pragma unroll
                for (int m = 0; m < 4; ++m)
#pragma unroll
                    for (int n = 0; n < 2; ++n) acc[a][b][m][n] = (f32x4){0.f, 0.f, 0.f, 0.f};
        cur = nxt; cA = nA; cB = nB; ++ui;
        if constexpr (ALIGN_EPI) { if (wr == 1) PG8_BAR; }
    }
    PG8_WAIT_V(0);
    if constexpr (!ALIGN_EPI) { if (wr == 0) PG8_BAR; }
    PG8_BAR;

#undef PG8_SA
#undef PG8_SB
#undef PG8_STAGE
#undef PG8_LDA
#undef PG8_LDB
#undef PG8_MMA
#undef PG8_WAIT_V
#undef PG8_WAIT_L
#undef PG8_BAR
#undef PG8_SCHED
}
#undef Unit

template <int MTW, int NTW = 4, class Epi>
DI void gemm_phase(const bf16_t* A, int lda, const bf16_t* Bt, int ldb, int K, int mbase, int mtiles, int ntiles, unsigned char* smem, Epi epi) {
  const int total = mtiles * ntiles, chunk = total >> 3;
  const int xcd = blockIdx.x & 7, li = blockIdx.x >> 3, per = gridDim.x >> 3;
  const int lane = tid() & 63, wid = tid() >> 6, wr = wid >> 2, wc = wid & 3;
  for (int q = li; q < chunk; q += per) {
    const int T = xcd * chunk + q;
    const int mg = T / (8 * ntiles), rem = T % (8 * ntiles);
    const int m0 = mbase + (mg * 8 + (rem & 7)) * (MTW * 32), n0 = (rem >> 3) * (NTW * 64);
    f32x4 acc[MTW][NTW];
#pragma unroll
    for (int i = 0; i < MTW; ++i)
#pragma unroll
      for (int j = 0; j < NTW; ++j) acc[i][j] = (f32x4){0.f, 0.f, 0.f, 0.f};
    GSeg sg{A, Bt, lda, ldb, K >> 6, m0, n0}, nx{A, Bt, lda, ldb, 0, m0, n0};
    if (q + per < chunk) {
      const int T2 = T + per, mg2 = T2 / (8 * ntiles), rem2 = T2 % (8 * ntiles);
      nx.nk = K >> 6; nx.m0 = mbase + (mg2 * 8 + (rem2 & 7)) * (MTW * 32); nx.n0 = (rem2 >> 3) * (NTW * 64);
    }
    gemm_mainloop<MTW, NTW>(sg, nx, smem, acc);
    epi(acc, m0 + wr * (MTW * 16) + (lane & 15), n0 + wc * (NTW * 16) + 4 * (lane >> 4));
  }
}

DI void phase_ffn_up(PR p, int which, int mrows, unsigned char* smem) {
  const bf16_t* H = (const bf16_t*)(p.ws + OFF_H);
  const bf16_t* W = (const bf16_t*)(p.ws + (which ? OFF_W13B : OFF_W13A));
  bf16_t* U = (bf16_t*)(p.ws + OFF_BIG);
  PG8Order S; S.init(0, mrows / 256, 2 * DFF / 256);
  const PG8Gemm g{H, W, D, D, D};
  pg8_gemm_phase((PG8_LAS unsigned char*)smem, g, S, [&](const f32x4 (&acc)[2][2][4][2], const PG8Unit& u, int wr, int wc, int fr, int fq) {
    const int row0 = u.pm * 256 + wr * 64 + fr;
    const int j0 = ((u.pn * 256 + wc * 32) >> 1) + 4 * fq;
#pragma unroll
    for (int ai = 0; ai < 2; ++ai)
#pragma unroll
      for (int m = 0; m < 4; ++m) {
        bf16_t* ur = U + (size_t)(row0 + ai * 128 + m * 16) * DFF + j0;
#pragma unroll
        for (int bj = 0; bj < 2; ++bj) {
          float o[4];
#pragma unroll
          for (int e = 0; e < 4; ++e) { const float a = acc[ai][bj][m][0][e], b = acc[ai][bj][m][1][e]; o[e] = a * __builtin_amdgcn_rcpf(1.f + __expf(-a)) * b; }
          uint2 v; v.x = pk(o[0], o[1]); v.y = pk(o[2], o[3]);
          *(uint2*)(ur + bj * 64) = v;
        }
      }
  });
}
DI void phase_gemm_res(PR p, int layer, const bf16_t* A, int lda, const bf16_t* W, int K, int modidx, float coef, int mrows, unsigned char* smem, bool first = false) {
  auto epi = [&](auto& acc, int row0, int col0) {
    constexpr int MTW = sizeof(acc) / sizeof(acc[0]), NTW = sizeof(acc[0]) / sizeof(acc[0][0]);
    const float* gv = modrow(p, layer, row0) + modidx * 1024 + col0;
    float4 g4[NTW];
#pragma unroll
    for (int nt = 0; nt < NTW; ++nt) { g4[nt] = *(const float4*)(gv + 16 * nt); g4[nt].x *= coef; g4[nt].y *= coef; g4[nt].z *= coef; g4[nt].w *= coef; }
#pragma unroll
    for (int mt = 0; mt < MTW; ++mt) {
      float* xr = xrow(p, row0 + 16 * mt) + col0;
      const float* xs = xsrc(p, row0 + 16 * mt, first) + col0;
#pragma unroll
      for (int nt = 0; nt < NTW; ++nt) {
        float4 x = *(const float4*)(xs + 16 * nt);
        x.x += g4[nt].x * acc[mt][nt][0]; x.y += g4[nt].y * acc[mt][nt][1]; x.z += g4[nt].z * acc[mt][nt][2]; x.w += g4[nt].w * acc[mt][nt][3];
        *(float4*)(xr + 16 * nt) = x;
      }
    }
  };
  {
    PG8Order S; S.init(0, ML / 256, D / 256);
    const PG8Gemm g{A, W, lda, K, K};
    pg8_gemm_phase((PG8_LAS unsigned char*)smem, g, S, [&](const f32x4 (&acc)[2][2][4][2], const PG8Unit& u, int wr, int wc, int fr, int fq) {
      const int row0 = u.pm * 256 + wr * 64 + fr, col0 = u.pn * 256 + wc * 32 + 4 * fq;
      const float* gv = modrow(p, layer, row0) + modidx * 1024 + col0;
      float4 g4[2][2];
#pragma unroll
      for (int bj = 0; bj < 2; ++bj)
#pragma unroll
        for (int n = 0; n < 2; ++n) { g4[bj][n] = *(const float4*)(gv + bj * 128 + n * 16); g4[bj][n].x *= coef; g4[bj][n].y *= coef; g4[bj][n].z *= coef; g4[bj][n].w *= coef; }
#pragma unroll
      for (int ai = 0; ai < 2; ++ai)
#pragma unroll
        for (int m = 0; m < 4; ++m) {
          float* xr = xrow(p, row0 + ai * 128 + m * 16) + col0;
          const float* xs = xsrc(p, row0 + ai * 128 + m * 16, first) + col0;
#pragma unroll
          for (int bj = 0; bj < 2; ++bj)
#pragma unroll
            for (int n = 0; n < 2; ++n) {
              float4 x = *(const float4*)(xs + bj * 128 + n * 16);
              x.x += g4[bj][n].x * acc[ai][bj][m][n][0]; x.y += g4[bj][n].y * acc[ai][bj][m][n][1];
              x.z += g4[bj][n].z * acc[ai][bj][m][n][2]; x.w += g4[bj][n].w * acc[ai][bj][m][n][3];
              *(float4*)(xr + bj * 128 + n * 16) = x;
            }
        }
    });
  }
  if (mrows > ML) gemm_phase<2, 2>(A, lda, W, K, K, ML, MC / 64, D / 128, smem, epi);
}

DI void phase_win(PR p, unsigned char* smem) {
  bf16_t* P = (bf16_t*)(p.ws + OFF_BIG);
  PG8Order S; S.init(0, ML / 256, INCP / 256);
  const PG8Gemm g{(const bf16_t*)(p.ws + OFF_H), (const bf16_t*)(p.ws + OFF_WIN), D, D, D};
  pg8_gemm_phase((PG8_LAS unsigned char*)smem, g, S, [&](const f32x4 (&acc)[2][2][4][2], const PG8Unit& u, int wr, int wc, int fr, int fq) {
    const int row0 = u.pm * 256 + wr * 64 + fr, col0 = u.pn * 256 + wc * 32 + 4 * fq;
#pragma unroll
    for (int ai = 0; ai < 2; ++ai)
#pragma unroll
      for (int m = 0; m < 4; ++m) {
        bf16_t* pr = P + (size_t)(row0 + ai * 128 + m * 16) * INCP + col0;
#pragma unroll
        for (int bj = 0; bj < 2; ++bj)
#pragma unroll
          for (int n = 0; n < 2; ++n)
            if (col0 + bj * 128 + n * 16 < INC) {
              uint2 v; v.x = pk(acc[ai][bj][m][n][0], acc[ai][bj][m][n][1]); v.y = pk(acc[ai][bj][m][n][2], acc[ai][bj][m][n][3]);
              *(uint2*)(pr + bj * 128 + n * 16) = v;
            }
      }
  });
  gemm_phase<2, 2>((const bf16_t*)(p.ws + OFF_H), D, (const bf16_t*)(p.ws + OFF_WIN), D, D, ML, MC / 64, INCP / 128, smem, [&](auto& acc, int row0, int col0) {
#pragma unroll
    for (int mt = 0; mt < 2; ++mt) {
      bf16_t* pr = P + (size_t)(row0 + 16 * mt) * INCP + col0;
#pragma unroll
      for (int nt = 0; nt < 2; ++nt)
        if (col0 + 16 * nt < INC) { uint2 v; v.x = pk(acc[mt][nt][0], acc[mt][nt][1]); v.y = pk(acc[mt][nt][2], acc[mt][nt][3]); *(uint2*)(pr + 16 * nt) = v; }
    }
  });
}
DI void phase_mla_up(PR p, unsigned char* smem) {
  const bf16_t* P = (const bf16_t*)(p.ws + OFF_BIG);
  float* Pf = (float*)(p.ws + OFF_BIG);
  auto epi_q = [&](f32x4 (&acc)[4][4], int row0, int col0) {
#pragma unroll
    for (int mt = 0; mt < 4; ++mt)
#pragma unroll
      for (int nt = 0; nt < 4; ++nt)
        if (col0 + 16 * nt < 384) *(f32x4*)(Pf + (size_t)(row0 + 16 * mt) * (INCP / 2) + col0 + 16 * nt) = acc[mt][nt];
  };
  gemm_phase<4>(P + 2048, INCP, (const bf16_t*)(p.ws + OFF_WUQ), 256, 256, 0, MT / 128, 2, smem, epi_q);
  auto epi_kv = [&](f32x4 (&acc)[4][4], int row0, int col0) {
#pragma unroll
    for (int mt = 0; mt < 4; ++mt)
#pragma unroll
      for (int nt = 0; nt < 4; ++nt) *(f32x4*)(Pf + (size_t)(row0 + 16 * mt) * (INCP / 2) + 384 + col0 + 16 * nt) = acc[mt][nt];
  };
  gemm_phase<4>(P + 2304, INCP, (const bf16_t*)(p.ws + OFF_WUKV), 128, 128, 0, MT / 128, 2, smem, epi_kv);
}

constexpr int VS = 34;
DI void write_vt_rows(const bf16_t* vt, int nrows, int b, int tok0, bf16_t* dst0, int heads0, int r0) {
  for (int c = tid(); c < nrows * 4; c += NTHR) {
    const int r = c >> 2, part = c & 3;
    const unsigned* s = (const unsigned*)(vt + (r0 + r) * VS + (part >> 1) * 16 + (part & 1) * 4);
    uint4 v; v.x = s[0]; v.y = s[1]; v.z = s[4]; v.w = s[5];
    *(uint4*)(dst0 + ((size_t)(b * heads0 + (r >> 6)) * 64 + (r & 63)) * KEYS + tok0 + part * 8) = v;
  }
}
DI void unpack8(const u32x4& w, float (&x)[8]) {
#pragma unroll
  for (int k = 0; k < 4; ++k) { x[2 * k] = __uint_as_float(w[k] << 16); x[2 * k + 1] = __uint_as_float(w[k] & 0xffff0000u); }
}
DI u32x4 pack8f(const float (&x)[8]) {
  u32x4 r;
#pragma unroll
  for (int k = 0; k < 4; ++k) r[k] = pk(x[2 * k], x[2 * k + 1]);
  return r;
}
DI void load8f(const float* g, float (&x)[8]) {
  const float4 a = *(const float4*)g, b = *(const float4*)(g + 4);
  x[0] = a.x; x[1] = a.y; x[2] = a.z; x[3] = a.w; x[4] = b.x; x[5] = b.y; x[6] = b.z; x[7] = b.w;
}
template <int PX>
DI void rope8(const float (&x)[8], float (&y)[8], const float2* T, float sgn) {
#pragma unroll
  for (int i = 0; i < 8; ++i) {
    const float pv = dppf<(PX == 1 ? 0xB1 : 0x4E)>(x[i]);
    const float2 cs = T[i];
    y[i] = x[i] * cs.x + sgn * pv * cs.y;
  }
}
constexpr int QK_T64 = 45056, QK_T32 = QK_T64 + 8192;
DI void phase_qkv(PR p, int layer, unsigned char* smem) {
  const int t = tid(), lane = t & 63, wave = t >> 6;
  bf16_t* P = (bf16_t*)(p.ws + OFF_BIG);
  bf16_t* vt = (bf16_t*)smem;
  float2* T64 = (float2*)(smem + QK_T64);
  float2* T32 = (float2*)(smem + QK_T32);
  if (blockIdx.x == 0 && t == 0) {
    const float* lv = p.in[18] + layer * 128;
    float a = 0.f, b = 0.f;
    for (int i = 0; i < 32; ++i) { a += lv[i] * lv[32 + i]; b += lv[64 + i] * lv[96 + i]; }
    const float lam_init = 0.8f - 0.6f * expf(-0.3f * (float)layer);
    ((float*)(p.ws + OFF_CTRL))[512 + layer] = expf(a) - expf(b) + lam_init;
  }
  for (int i = t; i < 1024; i += NTHR) {
    float sn, cs; sincosf((float)(i >> 4) * exp2f(-(float)(i & 15) * (13.287712379549449f / 16.f)), &sn, &cs);
    T64[i] = make_float2(cs, sn);
  }
  for (int i = t; i < 512; i += NTHR) {
    float sn, cs; sincosf((float)(i >> 3) * exp2f(-(float)(i & 7) * (13.287712379549449f / 8.f)), &sn, &cs);
    T32[i] = make_float2(cs, sn);
  }
  const int d8 = (lane & 7) * 8, e8 = (lane & 3) * 8;
  float g0[8], g1[8], g2[8], g3[8], g4[8];
  load8f((lane < 32 ? p.in[11] : p.in[12]) + layer * 64 + d8, g0);
  load8f(p.in[14] + layer * 64 + d8, g1);
  load8f(lane < 32 ? p.in[15] + layer * 64 + d8 : p.in[16] + layer * 32 + e8, g2);
  load8f(p.in[17] + layer * 32 + e8, g3);
  load8f(lane < 32 ? p.in[20] + layer * 256 + 8 * lane : p.in[21] + layer * 128 + 8 * (lane & 15), g4);
  const float sc64 = 0.125f * LOG2E, sc32 = 0.17677669529663687f * LOG2E;
  const float sg64 = (lane & 2) ? 1.f : -1.f, sg32 = (lane & 1) ? 1.f : -1.f;
  bf16_t* naQ = (bf16_t*)(p.ws + OFF_NA_Q); bf16_t* naK = (bf16_t*)(p.ws + OFF_NA_K);
  bf16_t* gQp = (bf16_t*)(p.ws + OFF_G_QP); bf16_t* gQn = (bf16_t*)(p.ws + OFF_G_QN); bf16_t* gK = (bf16_t*)(p.ws + OFF_G_K);
  bf16_t* dQp = (bf16_t*)(p.ws + OFF_D_QP); bf16_t* dQn = (bf16_t*)(p.ws + OFF_D_QN); bf16_t* dK = (bf16_t*)(p.ws + OFF_D_K);
  for (int unit = blockIdx.x; unit < MT / 32; unit += gridDim.x) {
    const int m0 = unit * 32;
    const bool isc = m0 >= ML;
    const int b = isc ? ((m0 - ML) >> 8) : (m0 >> 12);
    const int pos0 = isc ? ((m0 - ML) & 255) : (m0 & 4095);
    const int tok0 = isc ? (S + pos0) : pos0;
    u32x4 w[4][5];
#pragma unroll
    for (int tt = 0; tt < 4; ++tt)
#pragma unroll
      for (int j = 0; j < 5; ++j) {
        if (j < 4 || lane < 52) w[tt][j] = *(const u32x4*)(P + (size_t)(m0 + wave * 4 + tt) * INCP + 512 * j + 8 * lane);
        else w[tt][j] = (u32x4){0u, 0u, 0u, 0u};
      }
    __syncthreads();
#pragma unroll
    for (int tt = 0; tt < 4; ++tt) {
      const int tl = wave * 4 + tt, m = m0 + tl, pos = pos0 + tl, tok = tok0 + tl;
      const int prow = (pos >> 6) & 63, pcol = pos & 63;
      const float2* t64 = T64 + ((lane & 4) ? pcol : prow) * 16 + (lane & 1) * 8;
      const float2* t32 = T32 + ((lane & 2) ? pcol : prow) * 8;
      float x[8], y[8];
      float ss, s4, s8, r;
      unpack8(w[tt][0], x);
      ss = 0.f;
#pragma unroll
      for (int i = 0; i < 8; ++i) ss += x[i] * x[i];
      ss = sum8(ss);
      r = rsqrtf(ss * (1.f / 64.f) + EPS) * (lane < 32 ? sc64 : 1.f);
#pragma unroll
      for (int i = 0; i < 8; ++i) x[i] *= r * g0[i];
      *(u32x4*)((lane < 32 ? naQ : naK) + ((size_t)(b * 4 + ((lane >> 3) & 3)) * KEYS + tok) * 64 + d8) = pack8f(x);
      unpack8(w[tt][1], x);
      if (lane < 32) {
#pragma unroll
        for (int i = 0; i < 8; ++i) vt[((lane >> 3) * 64 + d8 + i) * VS + tl] = (bf16_t)(w[tt][1][i >> 1] >> (16 * (i & 1)));
      }
      ss = 0.f;
#pragma unroll
      for (int i = 0; i < 8; ++i) ss += x[i] * x[i];
      ss = sum8(ss);
      r = rsqrtf(ss * (1.f / 64.f) + EPS) * sc64;
#pragma unroll
      for (int i = 0; i < 8; ++i) x[i] *= r * g1[i];
      if (lane >= 32) *(u32x4*)(gQn + ((size_t)(b * 4 + (lane >> 3) - 4) * KEYS + tok) * 64 + d8) = pack8f(x);
      if (!isc) {
        rope8<2>(x, y, t64, sg64);
        if (lane >= 32) *(u32x4*)(gQp + ((size_t)(b * 4 + (lane >> 3) - 4) * S + pos) * 64 + d8) = pack8f(y);
      }
      unpack8(w[tt][2], x);
      if (lane >= 16 && lane < 32) {
#pragma unroll
        for (int i = 0; i < 8; ++i) vt[(256 + ((lane >> 3) - 2) * 64 + d8 + i) * VS + tl] = (bf16_t)(w[tt][2][i >> 1] >> (16 * (i & 1)));
      }
      ss = 0.f;
#pragma unroll
      for (int i = 0; i < 8; ++i) ss += x[i] * x[i];
      s4 = sum4(ss); s8 = s4 + dppf<0x141>(s4);
      r = lane < 32 ? rsqrtf(s8 * (1.f / 64.f) + EPS) : rsqrtf(s4 * (1.f / 32.f) + EPS) * sc32;
#pragma unroll
      for (int i = 0; i < 8; ++i) x[i] *= r * g2[i];
      if (lane >= 32) *(u32x4*)(dQn + ((size_t)(b * 8 + ((lane - 32) >> 2)) * KEYS + tok) * 32 + e8) = pack8f(x);
      if (!isc) {
        rope8<1>(x, y, t32, sg32);
        if (lane >= 32) *(u32x4*)(dQp + ((size_t)(b * 8 + ((lane - 32) >> 2)) * S + pos) * 32 + e8) = pack8f(y);
        rope8<2>(x, y, t64, sg64);
        if (lane < 16) *(u32x4*)(gK + ((size_t)(b * 2 + (lane >> 3)) * KEYS + tok) * 64 + d8) = pack8f(y);
      } else {
        if (lane < 16) *(u32x4*)(gK + ((size_t)(b * 2 + (lane >> 3)) * KEYS + tok) * 64 + d8) = pack8f(x);
      }
      unpack8(w[tt][3], x);
      if (lane >= 32) {
#pragma unroll
        for (int i = 0; i < 8; ++i) vt[(384 + ((lane - 32) >> 3) * 64 + d8 + i) * VS + tl] = (bf16_t)(w[tt][3][i >> 1] >> (16 * (i & 1)));
      }
      ss = 0.f;
#pragma unroll
      for (int i = 0; i < 8; ++i) ss += x[i] * x[i];
      s4 = sum4(ss);
      r = rsqrtf(s4 * (1.f / 32.f) + EPS);
#pragma unroll
      for (int i = 0; i < 8; ++i) x[i] *= r * g3[i];
      if (!isc) {
        rope8<1>(x, y, t32, sg32);
        if (lane < 32) *(u32x4*)(dK + ((size_t)(b * 8 + (lane >> 2)) * KEYS + tok) * 32 + e8) = pack8f(y);
      } else {
        if (lane < 32) *(u32x4*)(dK + ((size_t)(b * 8 + (lane >> 2)) * KEYS + tok) * 32 + e8) = pack8f(x);
      }
      unpack8(w[tt][4], x);
      ss = 0.f;
#pragma unroll
      for (int i = 0; i < 8; ++i) ss += x[i] * x[i];
      ss = sum16(ss);
      s8 = ss + shx(ss, 16);
      r = lane < 32 ? rsqrtf(s8 * (1.f / 256.f) + EPS) : rsqrtf(ss * (1.f / 128.f) + EPS);
#pragma unroll
      for (int i = 0; i < 8; ++i) x[i] *= r * g4[i];
      if (lane < 48) *(u32x4*)(P + (size_t)m * INCP + 2048 + 8 * lane) = pack8f(x);
    }
    __syncthreads();
    write_vt_rows(vt, 256, b, tok0, (bf16_t*)(p.ws + OFF_NA_VT), 4, 0);
    write_vt_rows(vt, 128, b, tok0, (bf16_t*)(p.ws + OFF_G_VT), 2, 256);
    write_vt_rows(vt, 256, b, tok0, (bf16_t*)(p.ws + OFF_D_VT), 4, 384);
  }
}

DI void phase_mla_post(PR p, int layer, unsigned char* smem) {
  const int t = tid(), lane = t & 63, wave = t >> 6, e = lane & 31;
  const bf16_t* P = (const bf16_t*)(p.ws + OFF_BIG);
  const float* Pf = (const float*)(p.ws + OFF_BIG);
  bf16_t* vt = (bf16_t*)smem;
  const float gq0 = p.in[24][layer * 96 + lane], gq1 = p.in[24][layer * 96 + 64 + e];
  const float gk0 = p.in[25][layer * 96 + lane], gk1 = p.in[25][layer * 96 + 64 + e];
  const float inv32 = exp2f(-(float)(lane & 7) * (13.287712379549449f / 8.f));
  const float sg32 = (lane & 8) ? 1.f : -1.f;
  const float sc96 = 0.10206207261596575f * LOG2E;
  bf16_t* mQp = (bf16_t*)(p.ws + OFF_M_QP); bf16_t* mQn = (bf16_t*)(p.ws + OFF_M_QN); bf16_t* mK = (bf16_t*)(p.ws + OFF_M_K);
  for (int unit = blockIdx.x; unit < MT / 32; unit += gridDim.x) {
    const int m0 = unit * 32;
    const bool isc = m0 >= ML;
    const int b = isc ? ((m0 - ML) >> 8) : (m0 >> 12);
    const int pos0 = isc ? ((m0 - ML) & 255) : (m0 & 4095);
    const int tok0 = isc ? (S + pos0) : pos0;
    float rq0[4][4], rq1[4][4], rk0[4][4], rvv[4][4], rkr[4];
#pragma unroll
    for (int tt = 0; tt < 4; ++tt) {
      const int m = m0 + wave * 4 + tt;
      const float* qraw = Pf + (size_t)m * (INCP / 2);
      rkr[tt] = lane < 32 ? bf2f(P[(size_t)m * INCP + 2432 + e]) : 0.f;
#pragma unroll
      for (int h = 0; h < 4; ++h) {
        rq0[tt][h] = qraw[h * 96 + lane];
        rq1[tt][h] = lane < 32 ? qraw[h * 96 + 64 + e] : 0.f;
        rk0[tt][h] = qraw[384 + h * 128 + lane];
        rvv[tt][h] = qraw[384 + h * 128 + 64 + lane];
      }
    }
    __syncthreads();
#pragma unroll
    for (int tt = 0; tt < 4; ++tt) {
      const int tl = wave * 4 + tt, pos = pos0 + tl, tok = tok0 + tl;
      float c32 = 1.f, s32 = 0.f;
      if (!isc) {
        const float frow = (float)(pos >> 6), fcol = (float)(pos & 63);
        sincosf(((lane & 16) ? fcol : frow) * inv32, &s32, &c32);
      }
      const float krp = rkr[tt];
#pragma unroll
      for (int h = 0; h < 4; ++h) {
        float q0 = rq0[tt][h], q1 = rq1[tt][h];
        float rs = rsqrtf(wsum64(q0 * q0 + q1 * q1) * (1.f / 96.f) + EPS);
        q0 = q0 * rs * gq0 * sc96; q1 = q1 * rs * gq1 * sc96;
        bf16_t* qn = mQn + ((size_t)(b * 4 + h) * KEYS + tok) * 96;
        qn[lane] = f2bf(q0);
        if (lane < 32) qn[64 + e] = f2bf(q1);
        if (!isc) {
          const float q1r = q1 * c32 + sg32 * dppf<0x128>(q1) * s32;
          bf16_t* qp = mQp + ((size_t)(b * 4 + h) * S + pos) * 96;
          qp[lane] = f2bf(q0);
          if (lane < 32) qp[64 + e] = f2bf(q1r);
        }
        float k0 = rk0[tt][h], k1 = krp;
        rs = rsqrtf(wsum64(k0 * k0 + k1 * k1) * (1.f / 96.f) + EPS);
        k0 = k0 * rs * gk0; k1 = k1 * rs * gk1;
        if (!isc) k1 = k1 * c32 + sg32 * dppf<0x128>(k1) * s32;
        bf16_t* kk = mK + ((size_t)(b * 4 + h) * KEYS + tok) * 96;
        kk[lane] = f2bf(k0);
        if (lane < 32) kk[64 + e] = f2bf(k1);
        vt[(h * 64 + lane) * VS + tl] = f2bf(rvv[tt][h]);
      }
    }
    __syncthreads();
    write_vt_rows(vt, 256, b, tok0, (bf16_t*)(p.ws + OFF_M_VT), 4, 0);
  }
}

constexpr int A_KBUF = 64 * 208, A_VBUF = 64 * 144, VSTR = 144;
constexpr int A_RPB = 2 * A_KBUF + 2 * A_VBUF;
constexpr int A_UNIT = A_RPB + 2048;

DI bf16x8 pack8(const f32x16& x, int s8) {
  u32x4 u;
  u.x = pk(x[s8 + 0], x[s8 + 1]); u.y = pk(x[s8 + 2], x[s8 + 3]); u.z = pk(x[s8 + 4], x[s8 + 5]); u.w = pk(x[s8 + 6], x[s8 + 7]);
  return __builtin_bit_cast(bf16x8, u);
}

template <int DK, bool NAM>
DI void attn_segment(const bf16x8 (&qf)[DK / 16], const bf16_t* __restrict__ Kg, const bf16_t* __restrict__ Vg, int ntiles, unsigned char* smem,
                     f32x16 (&ot)[2], float& m_run, f32x16& lsum, int qr, int qc, int key0, const float* rpb_l) {
  constexpr int KSTR = DK * 2 + 16, KCH = DK / 8, NKC = (64 * KCH + NTHR - 1) / NTHR;
  const int t = tid(), lane = t & 63, l31 = lane & 31, h = lane >> 5;
  u32x4 rk0[NKC], rk1[NKC], rv0, rv1;
  const int r0 = min(max(qr - 4, 0), 56), c0 = min(max(qc - 8, 0), 48);
  const bf16x8 ones = {16256, 16256, 16256, 16256, 16256, 16256, 16256, 16256};
  f32x16 zero16;
#pragma unroll
  for (int i = 0; i < 16; ++i) zero16[i] = 0.f;
#define ATT_LOADK(it, RK)                                                                                          \
  {                                                                                                                \
    const u32x4* ks = (const u32x4*)(Kg + (size_t)(it) * 64 * DK);                                                 \
    _Pragma("unroll") for (int i = 0; i < NKC; ++i) {                                                              \
      const int c = t + NTHR * i;                                                                                  \
      if (c < 64 * KCH) RK[i] = ks[c];                                                                             \
    }                                                                                                              \
  }
#define ATT_LOADV(it, RV) { RV = *(const u32x4*)(Vg + (size_t)(t >> 3) * KEYS + (it) * 64 + (t & 7) * 8); }
#define ATT_STOREK(buf, RK)                                                                                        \
  {                                                                                                                \
    unsigned char* kb_ = smem + (buf) * A_KBUF;                                                                    \
    _Pragma("unroll") for (int i = 0; i < NKC; ++i) {                                                              \
      const int c = t + NTHR * i;                                                                                  \
      if (c < 64 * KCH) *(u32x4*)(kb_ + (c / KCH) * KSTR + (c % KCH) * 16) = RK[i];                                \
    }                                                                                                              \
  }
#define ATT_STOREV(buf, RV)                                                                                        \
  {                                                                                                                \
    *(u32x4*)(smem + 2 * A_KBUF + (buf) * A_VBUF + (t >> 3) * VSTR + (t & 7) * 16) = RV;                           \
  }
#define ATT_QK(buf)                                                                                                \
  {                                                                                                                \
    const unsigned char* kb_ = smem + (buf) * A_KBUF;                                                              \
    _Pragma("unroll") for (int tt = 0; tt < 2; ++tt)                                                               \
      _Pragma("unroll") for (int s = 0; s < DK / 16; ++s) {                                                        \
        const bf16x8 kf = *(const bf16x8*)(kb_ + (32 * tt + l31) * KSTR + (16 * s + 8 * h) * 2);                   \
        st[tt] = __builtin_amdgcn_mfma_f32_32x32x16_bf16(kf, qf[s], s == 0 ? zero16 : st[tt], 0, 0, 0);            \
      }                                                                                                            \
  }
#define ATT_PV(buf) { ATT_PVH(buf, 0); ATT_PVH(buf, 1); }
#define ATT_PVH(buf, tt)                                                                                           \
  {                                                                                                                \
    const unsigned char* vb_ = smem + 2 * A_KBUF + (buf) * A_VBUF;                                                 \
      _Pragma("unroll") for (int s = 0; s < 2; ++s) {                                                              \
        lsum = __builtin_amdgcn_mfma_f32_32x32x16_bf16(ones, pf[tt][s], lsum, 0, 0, 0);                            \
        _Pragma("unroll") for (int d = 0; d < 2; ++d) {                                                            \
          const bf16x8 vf = *(const bf16x8*)(vb_ + (32 * d + l31) * VSTR + (32 * tt + 16 * s + 8 * h) * 2);        \
          ot[d] = __builtin_amdgcn_mfma_f32_32x32x16_bf16(vf, pf[tt][s], ot[d], 0, 0, 0);                          \
        }                                                                                                          \
      }                                                                                                            \
  }
  ATT_LOADK(0, rk0);
  ATT_LOADK(1, rk1);
  __syncthreads();
  ATT_STOREK(0, rk0);
  ATT_STOREK(1, rk1);
  ATT_LOADK(2, rk0);
  ATT_LOADV(0, rv0);
  __syncthreads();
  f32x16 st[2];
  ATT_QK(0);
  __syncthreads();
  bf16x8 pf[2][2];
#define ATT_ITER(it, PAR, RKL, RVL, RKS, RVS, DO_PV, DO_QK)                                                          \
  {                                                                                                                \
    if ((it) + 3 < ntiles) ATT_LOADK((it) + 3, RKL);                                                               \
    if ((it) + 1 < ntiles) ATT_LOADV((it) + 1, RVL);                                                               \
    if (DO_PV) ATT_PVH((PAR) ^ 1, 0);                                                                              \
    if (NAM) {                                                                                                     \
      _Pragma("unroll") for (int tt = 0; tt < 2; ++tt)                                                             \
        _Pragma("unroll") for (int i = 0; i < 16; ++i) {                                                           \
          const int kidx = key0 + (it) * 64 + 32 * tt + (i & 3) + 8 * (i >> 2) + 4 * h;                            \
          const int kr = kidx >> 6, kc = kidx & 63;                                                                \
          const bool valid = (kr >= r0) && (kr < r0 + 8) && (kc >= c0) && (kc < c0 + 16);                          \
          const int idx = valid ? (kr - qr + 7) * 31 + (kc - qc + 15) : 0;                                         \
          const float bias = rpb_l[idx];                                                                           \
          st[tt][i] = valid ? st[tt][i] + bias : -1e30f;                                                           \
        }                                                                                                          \
    }                                                                                                              \
    float mx = fmaxf(fmaxf(st[0][0], st[0][1]), st[0][2]);                                                         \
    _Pragma("unroll") for (int i = 3; i < 15; i += 2) mx = fmaxf(fmaxf(mx, st[0][i]), st[0][i + 1]);               \
    mx = fmaxf(fmaxf(mx, st[0][15]), st[1][0]);                                                                    \
    _Pragma("unroll") for (int i = 1; i < 15; i += 2) mx = fmaxf(fmaxf(mx, st[1][i]), st[1][i + 1]);               \
    mx = fmaxf(mx, st[1][15]);                                                                                     \
    mx = fmaxf(mx, shx(mx, 32)) - m_run;                                                                           \
    __builtin_amdgcn_sched_barrier(0);                                                                             \
    if (DO_PV) ATT_PVH((PAR) ^ 1, 1);                                                                              \
    _Pragma("unroll") for (int tt = 0; tt < 2; ++tt)                                                               \
      _Pragma("unroll") for (int i = 0; i < 16; ++i) st[tt][i] = __builtin_amdgcn_exp2f(st[tt][i] - m_run);        \
    if (__builtin_amdgcn_ballot_w64(mx > 8.f) != 0ull) {                                                           \
      const float delta = fmaxf(mx, 0.f);                                                                          \
      const float alpha = __builtin_amdgcn_exp2f(-delta);                                                          \
      m_run += delta;                                                                                              \
      _Pragma("unroll") for (int i = 0; i < 16; ++i) {                                                             \
        st[0][i] *= alpha; st[1][i] *= alpha;                                                                      \
        ot[0][i] *= alpha; ot[1][i] *= alpha; lsum[i] *= alpha;                                                    \
      }                                                                                                            \
    }                                                                                                              \
    _Pragma("unroll") for (int tt = 0; tt < 2; ++tt)                                                               \
      _Pragma("unroll") for (int s = 0; s < 2; ++s) pf[tt][s] = pack8(st[tt], 8 * s);                              \
    if (DO_QK) ATT_QK((PAR) ^ 1);                                                                                  \
    if ((it) + 2 < ntiles) ATT_STOREK(PAR, RKS);                                                                   \
    ATT_STOREV(PAR, RVS);                                                                                          \
    __syncthreads();                                                                                               \
  }
  ATT_ITER(0, 0, rk1, rv1, rk0, rv0, false, true);
#pragma unroll 1
  for (int it = 1; it < ntiles - 1; it += 2) {
    ATT_ITER(it, 1, rk0, rv0, rk1, rv1, true, true);
    ATT_ITER(it + 1, 0, rk1, rv1, rk0, rv0, true, true);
  }
  ATT_ITER(ntiles - 1, 1, rk0, rv0, rk1, rv1, true, false);
#undef ATT_ITER
  ATT_PV(1);
#undef ATT_LOADK
#undef ATT_LOADV
#undef ATT_STOREK
#undef ATT_STOREV
#undef ATT_QK
#undef ATT_PV
#undef ATT_PVH
}

template <int DK, bool NAM>
DI void attn_run(const bf16_t* Qn_w, const bf16_t* Qp_w, const bf16_t* Kbh, const bf16_t* Vtbh, int lat_key0, int lat_tiles, unsigned char* smem,
                 f32x16 (&ot)[2], int qr, int qc, const float* rpb_l) {
  const int lane = tid() & 63, l31 = lane & 31, h = lane >> 5;
  float m_run = 0.f;
  f32x16 lsum;
#pragma unroll
  for (int i = 0; i < 16; ++i) { ot[0][i] = 0.f; ot[1][i] = 0.f; lsum[i] = 0.f; }
  bf16x8 qf[DK / 16];
#pragma unroll
  for (int s = 0; s < DK / 16; ++s) qf[s] = *(const bf16x8*)(Qn_w + l31 * DK + 16 * s + 8 * h);
  attn_segment<DK, false>(qf, Kbh + (size_t)S * DK, Vtbh + S, CL / 64, smem, ot, m_run, lsum, qr, qc, 0, rpb_l);
  if (Qp_w) {
#pragma unroll
    for (int s = 0; s < DK / 16; ++s) qf[s] = *(const bf16x8*)(Qp_w + l31 * DK + 16 * s + 8 * h);
    attn_segment<DK, NAM>(qf, Kbh + (size_t)lat_key0 * DK, Vtbh + lat_key0, lat_tiles, smem, ot, m_run, lsum, qr, qc, lat_key0, rpb_l);
  }
  const float inv = 1.f / lsum[0];
#pragma unroll
  for (int d = 0; d < 2; ++d)
#pragma unroll
    for (int i = 0; i < 16; ++i) ot[d][i] *= inv;
}
DI void store_o(bf16_t* orow, const f32x16 (&ot)[2], int h) {
#pragma unroll
  for (int d = 0; d < 2; ++d)
#pragma unroll
    for (int g = 0; g < 4; ++g) {
      uint2 v; v.x = pk(ot[d][4 * g], ot[d][4 * g + 1]); v.y = pk(ot[d][4 * g + 2], ot[d][4 * g + 3]);
      *(uint2*)(orow + 32 * d + 8 * g + 4 * h) = v;
    }
}

DI bf16_t* att_orow(PR p, int b, int br, int head, int qoff, bool isc) {
  const int l31 = tid() & 31;
  const int mrow = isc ? (ML + b * CL + (qoff - S) + l31) : (b * S + qoff + l31);
  return (bf16_t*)(p.ws + OFF_BIG) + (size_t)mrow * D + br * 256 + head * 64;
}
template <class F>
DI void att_unit_loop(PR p, int layer, int br, int nunits, unsigned char* smem, int rep, F body) {
  const int t = tid(), wave = __builtin_amdgcn_readfirstlane(t >> 6);
  const int b = blockIdx.x & 7;
  int* cnt = (int*)(p.ws + OFF_CTRL) + (layer * 8 + b) * 4 + br + rep * 128;
  int* s_unit = (int*)(smem + A_UNIT);
  while (true) {
    __syncthreads();
    if (t == 0) *s_unit = atomicAdd(cnt, 1);
    __syncthreads();
    const int u = *s_unit;
    if (u >= nunits) break;
    const bool isc = u >= 64;
    const int head = isc ? ((u - 64) & 3) : (u >> 4);
    const int qoff = isc ? (S + wave * 32) : ((u & 15) * 256 + wave * 32);
    body(head, qoff, isc);
  }
}

DI void phase_attn(PR p, int layer, bool need_ctx, unsigned char* smem, int rep) {
  const int t = tid(), lane = t & 63, wave = __builtin_amdgcn_readfirstlane(t >> 6), l31 = lane & 31, h = lane >> 5;
  const int b = blockIdx.x & 7;
  const int nunits = need_ctx ? 68 : 64;
  float* rpb_l = (float*)(smem + A_RPB);
  att_unit_loop(p, layer, 3, nunits, smem, rep, [&](int head, int qoff, bool isc) {
    f32x16 o1[2];
    const bf16_t* qn = (const bf16_t*)(p.ws + OFF_M_QN) + ((size_t)(b * 4 + head) * KEYS + qoff) * 96;
    const bf16_t* qp = isc ? nullptr : (const bf16_t*)(p.ws + OFF_M_QP) + ((size_t)(b * 4 + head) * S + qoff) * 96;
    attn_run<96, false>(qn, qp, (const bf16_t*)(p.ws + OFF_M_K) + (size_t)(b * 4 + head) * KEYS * 96,
                        (const bf16_t*)(p.ws + OFF_M_VT) + (size_t)(b * 4 + head) * 64 * KEYS, 0, S / 64, smem, o1, 0, 0, rpb_l);
    store_o(att_orow(p, b, 3, head, qoff, isc), o1, h);
  });
  {
    att_unit_loop(p, layer, 2, nunits, smem, rep, [&](int head, int qoff, bool isc) {
      f32x16 o2[2];
      const bf16_t* vt = (const bf16_t*)(p.ws + OFF_D_VT) + (size_t)(b * 4 + head) * 64 * KEYS;
      float* scr = (float*)(p.ws + OFF_SCR) + (size_t)blockIdx.x * 16384 + t;
      {
        const int g = b * 8 + head * 2;
        const bf16_t* qn = (const bf16_t*)(p.ws + OFF_D_QN) + ((size_t)g * KEYS + qoff) * 32;
        const bf16_t* qp = isc ? nullptr : (const bf16_t*)(p.ws + OFF_D_QP) + ((size_t)g * S + qoff) * 32;
        attn_run<32, false>(qn, qp, (const bf16_t*)(p.ws + OFF_D_K) + (size_t)g * KEYS * 32, vt, 0, S / 64, smem, o2, 0, 0, rpb_l);
      }
#pragma unroll
      for (int d = 0; d < 2; ++d)
#pragma unroll
        for (int i = 0; i < 16; ++i) scr[(d * 16 + i) * NTHR] = o2[d][i];
      {
        const int g = b * 8 + head * 2 + 1;
        const bf16_t* qn = (const bf16_t*)(p.ws + OFF_D_QN) + ((size_t)g * KEYS + qoff) * 32;
        const bf16_t* qp = isc ? nullptr : (const bf16_t*)(p.ws + OFF_D_QP) + ((size_t)g * S + qoff) * 32;
        attn_run<32, false>(qn, qp, (const bf16_t*)(p.ws + OFF_D_K) + (size_t)g * KEYS * 32, vt, 0, S / 64, smem, o2, 0, 0, rpb_l);
      }
      const float lam = ((const float*)(p.ws + OFF_CTRL))[512 + layer];
      const float lam_init = 0.8f - 0.6f * expf(-0.3f * (float)layer);
      const float* gs = p.in[19] + layer * 64;
      const float* scr2 = (const float*)(p.ws + OFF_SCR) + (size_t)blockIdx.x * 16384 + tid();
      float ss = 0.f;
#pragma unroll
      for (int d = 0; d < 2; ++d)
#pragma unroll
        for (int i = 0; i < 16; ++i) { const float v = scr2[(d * 16 + i) * NTHR] - lam * o2[d][i]; o2[d][i] = v; ss += v * v; }
      ss += shx(ss, 32);
      const float rs = rsqrtf(ss * (1.f / 64.f) + EPS) * (1.f - lam_init);
#pragma unroll
      for (int d = 0; d < 2; ++d)
#pragma unroll
        for (int i = 0; i < 16; ++i) o2[d][i] *= rs * gs[32 * d + 8 * (i >> 2) + 4 * h + (i & 3)];
      store_o(att_orow(p, b, 2, head, qoff, isc), o2, h);
    });
  }
  att_unit_loop(p, layer, 1, nunits, smem, rep, [&](int head, int qoff, bool isc) {
    f32x16 o1[2];
    const bf16_t* qn = (const bf16_t*)(p.ws + OFF_G_QN) + ((size_t)(b * 4 + head) * KEYS + qoff) * 64;
    const bf16_t* qp = isc ? nullptr : (const bf16_t*)(p.ws + OFF_G_QP) + ((size_t)(b * 4 + head) * S + qoff) * 64;
    const int g = b * 2 + (head >> 1);
    attn_run<64, false>(qn, qp, (const bf16_t*)(p.ws + OFF_G_K) + (size_t)g * KEYS * 64,
                        (const bf16_t*)(p.ws + OFF_G_VT) + (size_t)g * 64 * KEYS, 0, S / 64, smem, o1, 0, 0, rpb_l);
    store_o(att_orow(p, b, 1, head, qoff, isc), o1, h);
  });
  att_unit_loop(p, layer, 0, nunits, smem, rep, [&](int head, int qoff, bool isc) {
    f32x16 o1[2];
    for (int i = t; i < 465; i += NTHR) rpb_l[i] = p.in[13][(size_t)(layer * 4 + head) * 465 + i] * LOG2E;
    const bf16_t* qn = (const bf16_t*)(p.ws + OFF_NA_Q) + ((size_t)(b * 4 + head) * KEYS + qoff) * 64;
    const int qidx = qoff + l31;
    const int qrow0 = (qoff - wave * 32) >> 6;
    const int rs = min(min(max(qrow0 - 4, 0), 56), 52);
    attn_run<64, true>(qn, isc ? nullptr : qn, (const bf16_t*)(p.ws + OFF_NA_K) + (size_t)(b * 4 + head) * KEYS * 64,
                       (const bf16_t*)(p.ws + OFF_NA_VT) + (size_t)(b * 4 + head) * 64 * KEYS, rs * 64, 12, smem, o1, qidx >> 6, qidx & 63, rpb_l);
    store_o(att_orow(p, b, 0, head, qoff, isc), o1, h);
  });
}

template <int MTW>
DI void merge_tiles(PR p, int layer, int mbase, int mtiles, unsigned char* smem) {
  const bf16_t* H = (const bf16_t*)(p.ws + OFF_H);
  const bf16_t* O = (const bf16_t*)(p.ws + OFF_BIG);
  bf16_t* Y = (bf16_t*)(p.ws + OFF_Y);
  const bf16_t* WG = (const bf16_t*)(p.ws + OFF_WG);
  const bf16_t* WB = (const bf16_t*)(p.ws + OFF_WB);
  const int ntiles = D / 256;
  const int total = mtiles * ntiles, chunk = total >> 3;
  const int xcd = blockIdx.x & 7, li = blockIdx.x >> 3, per = gridDim.x >> 3;
  const int lane = tid() & 63, wid = tid() >> 6, wr = wid >> 2, wc = wid & 3;
  for (int q = li; q < chunk; q += per) {
    const int T = xcd * chunk + q;
    const int mg = T / (8 * ntiles), rem = T % (8 * ntiles);
    const int m0 = mbase + (mg * 8 + (rem & 7)) * (MTW * 32), n0 = (rem >> 3) * 256;
    const int row0 = m0 + wr * (MTW * 16) + (lane & 15), col0 = n0 + wc * 64 + 4 * (lane >> 4);
    unsigned ypk[MTW][4][2];
#pragma unroll
    for (int i = 0; i < MTW; ++i)
#pragma unroll
      for (int j = 0; j < 4; ++j) { ypk[i][j][0] = 0u; ypk[i][j][1] = 0u; }
#pragma unroll 1
    for (int j = 0; j < 4; ++j) {
      f32x4 accG[MTW][4];
#pragma unroll
      for (int i = 0; i < MTW; ++i)
#pragma unroll
        for (int k = 0; k < 4; ++k) accG[i][k] = (f32x4){0.f, 0.f, 0.f, 0.f};
      const GSeg sgG{H, WG + (size_t)j * D * D, D, D, D >> 6, m0, n0}, sgB{O + j * 256, WB + (size_t)j * D * 256, D, 256, 4, m0, n0};
      GSeg nxG{H, WG + (size_t)(j + 1) * D * D, D, D, j < 3 ? (D >> 6) : 0, m0, n0};
      if (j == 3 && q + per < chunk) {
        const int T2 = T + per, mg2 = T2 / (8 * ntiles), rem2 = T2 % (8 * ntiles);
        nxG.Bt = WG; nxG.nk = D >> 6; nxG.m0 = mbase + (mg2 * 8 + (rem2 & 7)) * (MTW * 32); nxG.n0 = (rem2 >> 3) * 256;
      }
      gemm_mainloop<MTW>(sgG, sgB, smem, accG);
      unsigned gpk[MTW][4][2];
      const float* bg = p.in[27] + (size_t)(layer * 4 + j) * D + col0;
#pragma unroll
      for (int nt = 0; nt < 4; ++nt) {
        const float4 b4 = *(const float4*)(bg + 16 * nt);
#pragma unroll
        for (int mt = 0; mt < MTW; ++mt) {
          const float g0 = __builtin_amdgcn_rcpf(1.f + __expf(-(accG[mt][nt][0] + b4.x))), g1 = __builtin_amdgcn_rcpf(1.f + __expf(-(accG[mt][nt][1] + b4.y)));
          const float g2 = __builtin_amdgcn_rcpf(1.f + __expf(-(accG[mt][nt][2] + b4.z))), g3 = __builtin_amdgcn_rcpf(1.f + __expf(-(accG[mt][nt][3] + b4.w)));
          gpk[mt][nt][0] = pk(g0, g1); gpk[mt][nt][1] = pk(g2, g3);
        }
      }
#pragma unroll
      for (int i = 0; i < MTW; ++i)
#pragma unroll
        for (int k = 0; k < 4; ++k) accG[i][k] = (f32x4){0.f, 0.f, 0.f, 0.f};
      gemm_mainloop<MTW>(sgB, nxG, smem, accG);
#pragma unroll
      for (int mt = 0; mt < MTW; ++mt)
#pragma unroll
        for (int nt = 0; nt < 4; ++nt) {
          const float y0 = __uint_as_float(ypk[mt][nt][0] << 16) + __uint_as_float(gpk[mt][nt][0] << 16) * accG[mt][nt][0];
          const float y1 = __uint_as_float(ypk[mt][nt][0] & 0xffff0000u) + __uint_as_float(gpk[mt][nt][0] & 0xffff0000u) * accG[mt][nt][1];
          const float y2 = __uint_as_float(ypk[mt][nt][1] << 16) + __uint_as_float(gpk[mt][nt][1] << 16) * accG[mt][nt][2];
          const float y3 = __uint_as_float(ypk[mt][nt][1] & 0xffff0000u) + __uint_as_float(gpk[mt][nt][1] & 0xffff0000u) * accG[mt][nt][3];
          ypk[mt][nt][0] = pk(y0, y1); ypk[mt][nt][1] = pk(y2, y3);
        }
    }
#pragma unroll
    for (int mt = 0; mt < MTW; ++mt)
#pragma unroll
      for (int nt = 0; nt < 4; ++nt) {
        uint2 v; v.x = ypk[mt][nt][0]; v.y = ypk[mt][nt][1];
        *(uint2*)(Y + (size_t)(row0 + 16 * mt) * D + col0 + 16 * nt) = v;
      }
  }
}

#define XB_TMO      128
#define XB_XCNT(j)  (256  + 64 * (j))
#define XB_XSUB(j)  (1280 + 64 * (j))
#define XB_XGEN(j)  (2304 + 64 * (j))
#define XB_TOP      3328
#define XB_TOPGEN   3392
#define XCD_BAR_WORDS 3456
#define XB_SPIN_CAP (1u << 20)
#define LAS __attribute__((address_space(3)))
DI unsigned xb_ld(unsigned* p)              { return __hip_atomic_load(p, __ATOMIC_RELAXED, __HIP_MEMORY_SCOPE_AGENT); }
DI unsigned xb_add(unsigned* p, unsigned v) { return __hip_atomic_fetch_add(p, v, __ATOMIC_RELAXED, __HIP_MEMORY_SCOPE_AGENT); }
DI unsigned xb_xcc_id() { return (unsigned)__builtin_amdgcn_s_getreg((3 << 11) | 20) & 0xFu; }
#define XB_SPIN(cond, bar) do { unsigned _sp = 0; while (cond) { __builtin_amdgcn_s_sleep(1); \
    if ((++_sp & 255u) == 0u) { if (xb_ld(&(bar)[XB_TMO])) break; if (_sp > XB_SPIN_CAP) { atomicAdd(&(bar)[XB_TMO], 1u); break; } } } } while (0)
struct XcdBarrier { unsigned* bar; unsigned x; volatile LAS unsigned* st; };
DI XcdBarrier xcd_barrier_post(unsigned* bar, volatile LAS unsigned* st) {
  XcdBarrier b; b.bar = bar; b.x = xb_xcc_id(); b.st = st;
  if (threadIdx.x == 0) (void)xb_add(&bar[XB_XCNT(b.x)], 1u);
  return b;
}
DI void xcd_barrier_complete(unsigned* bar, unsigned x, unsigned& nloc, unsigned& nx) {
  const unsigned G = gridDim.x * gridDim.y * gridDim.z;
  unsigned sum, cnt, mine, sp = 0u;
  for (;;) {
    sum = 0u; cnt = 0u; mine = 0u;
#pragma unroll
    for (unsigned j = 0; j < 16; ++j) { const unsigned c = xb_ld(&bar[XB_XCNT(j)]); sum += c; cnt += (c > 0u) ? 1u : 0u; mine = (j == x) ? c : mine; }
    if (sum == G) break;
    __builtin_amdgcn_s_sleep(1);
    if ((++sp & 255u) == 0u) { if (xb_ld(&bar[XB_TMO])) break; if (sp > XB_SPIN_CAP) { atomicAdd(&bar[XB_TMO], 1u); break; } }
  }
  nloc = mine > 0u ? mine : 1u; nx = cnt > 0u ? cnt : 1u;
}
DI void xcd_barrier(const XcdBarrier& b) {
  asm volatile("s_waitcnt vmcnt(0)" ::: "memory");
  __syncthreads();
  if (threadIdx.x == 0) {
    unsigned* bar = b.bar;
    __builtin_amdgcn_s_waitcnt(0);
    unsigned nloc = b.st[0], nx = b.st[1];
    if (nloc == 0u) { xcd_barrier_complete(bar, b.x, nloc, nx); b.st[0] = nloc; b.st[1] = nx; }
    const unsigned old = xb_add(&bar[XB_XSUB(b.x)], 1u);
    const unsigned gen = old / nloc;
    if (old + 1u == (gen + 1u) * nloc) {
      __builtin_amdgcn_fence(__ATOMIC_RELEASE, "agent");
      asm volatile("s_waitcnt vmcnt(0)" ::: "memory");
      const unsigned og = xb_add(&bar[XB_TOP], 1u);
      const unsigned tg = og / nx;
      if (og + 1u == (tg + 1u) * nx) xb_add(&bar[XB_TOPGEN], 1u);
      else XB_SPIN(xb_ld(&bar[XB_TOPGEN]) == tg, bar);
      __builtin_amdgcn_fence(__ATOMIC_ACQUIRE, "agent");
      xb_add(&bar[XB_XGEN(b.x)], 1u);
      asm volatile("s_waitcnt vmcnt(0)" ::: "memory");
    } else {
      XB_SPIN(xb_ld(&bar[XB_XGEN(b.x)]) == gen, bar);
      __builtin_amdgcn_fence(__ATOMIC_ACQUIRE, "agent");
      asm volatile("s_waitcnt vmcnt(0)" ::: "memory");
    }
  }
  __syncthreads();
}

DI void phase_merge(PR p, int layer, int mrows, unsigned char* smem) {
  merge_tiles<4>(p, layer, 0, ML / 128, smem);
  if (mrows > ML) merge_tiles<2>(p, layer, ML, MC / 64, smem);
}

DI void ctr_barrier(unsigned* ctr, unsigned& epoch) {
  asm volatile("s_waitcnt vmcnt(0)" ::: "memory");
  __syncthreads();
  epoch += 1u;
  if (threadIdx.x == 0) {
    __builtin_amdgcn_fence(__ATOMIC_RELEASE, "agent");
    asm volatile("s_waitcnt vmcnt(0)" ::: "memory");
    (void)xb_add(ctr, 1u);
    const unsigned target = epoch * gridDim.x;
    unsigned sp = 0u;
    while (xb_ld(ctr) < target) { __builtin_amdgcn_s_sleep(1); if (++sp > (1u << 22)) break; }
    __builtin_amdgcn_fence(__ATOMIC_ACQUIRE, "agent");
    asm volatile("s_waitcnt vmcnt(0)" ::: "memory");
  }
  __syncthreads();
}

#ifndef RP_UP
#define RP_UP 0
#endif
#ifndef RP_DOWN
#define RP_DOWN 0
#endif
#ifndef RP_WIN
#define RP_WIN 0
#endif
#ifndef RP_MERGE
#define RP_MERGE 0
#endif
#ifndef RP_OUT
#define RP_OUT 0
#endif
#ifndef RP_ATTN
#define RP_ATTN 0
#endif
#ifndef RP_TOK
#define RP_TOK 0
#endif
#ifndef RP_NORM
#define RP_NORM RP_TOK
#endif
#ifndef RP_QKV
#define RP_QKV RP_TOK
#endif
#ifndef RP_MLAUP
#define RP_MLAUP RP_TOK
#endif
#ifndef RP_MLAPOST
#define RP_MLAPOST RP_TOK
#endif
#ifndef RP_SYNC
#define RP_SYNC 0
#endif
__global__ void __launch_bounds__(512, 2) fwd_megakernel(Params p) {
  cg::grid_group grid = cg::this_grid();
  __shared__ __attribute__((aligned(1024))) unsigned char smem[LDS_BYTES];
  KP kp = (KP)__builtin_amdgcn_kernarg_segment_ptr();
#define P_ (*({ asm volatile("" : "+s"(kp)); kp; }))
  __shared__ uint4 xb_words;
  if (threadIdx.x == 0) xb_words = make_uint4(0u, 0u, 0u, 0u);
  __syncthreads();
  unsigned* const xb = (unsigned*)(kp->ws + OFF_BAR) + 256;
  if (blockIdx.x == 0) for (int i = threadIdx.x; i < XCD_BAR_WORDS; i += NTHR) xb[i - 256] = 0u;
  phase_prologue(P_, smem);
  grid.sync();
  unsigned bar_epoch = 0;
#pragma unroll 1
  for (int layer = 0; layer < DEPTH; ++layer) {
    const bool need_ctx = layer < DEPTH - 1;
    const int mlate = need_ctx ? MT : ML;
    if (layer > 0) conv_ffn(P_, layer, 1, smem);
    for (int r = 0; r <= RP_NORM; ++r) { phase_norm(P_, layer, 0, 0, 1, MT, layer == 0); ctr_barrier(xb, bar_epoch); }
    for (int r = 0; r <= RP_UP; ++r) { phase_ffn_up(P_, 0, MT, smem); ctr_barrier(xb, bar_epoch); }
    for (int r = 0; r <= RP_DOWN; ++r) {
      phase_gemm_res(P_, layer, (const bf16_t*)(P_.ws + OFF_BIG), DFF, (const bf16_t*)(P_.ws + OFF_W2A), DFF, 2, r ? 0.f : 0.5f, MT, smem, layer == 0 && r == 0);
      ctr_barrier(xb, bar_epoch);
    }
    if (layer + 1 < DEPTH) conv_ffn(P_, layer + 1, 0, smem);
    for (int r = 0; r <= RP_NORM; ++r) { phase_norm(P_, layer, 1, 3, 4, MT); ctr_barrier(xb, bar_epoch); }
    for (int r = 0; r <= RP_WIN; ++r) { phase_win(P_, smem); ctr_barrier(xb, bar_epoch); }
    for (int r = 0; r <= RP_QKV; ++r) { phase_qkv(P_, layer, smem); ctr_barrier(xb, bar_epoch); }
    for (int r = 0; r <= RP_MLAUP; ++r) { phase_mla_up(P_, smem); ctr_barrier(xb, bar_epoch); }
    for (int r = 0; r < RP_SYNC; ++r) ctr_barrier(xb, bar_epoch);
    for (int r = 0; r <= RP_MLAPOST; ++r) { phase_mla_post(P_, layer, smem); ctr_barrier(xb, bar_epoch); }
    for (int r = 0; r <= RP_ATTN; ++r) { phase_attn(P_, layer, need_ctx, smem, r); ctr_barrier(xb, bar_epoch); }
    for (int r = 0; r <= RP_MERGE; ++r) { phase_merge(P_, layer, mlate, smem); ctr_barrier(xb, bar_epoch); }
    for (int r = 0; r <= RP_OUT; ++r) {
      phase_gemm_res(P_, layer, (const bf16_t*)(P_.ws + OFF_Y), D, (const bf16_t*)(P_.ws + OFF_WO), D, 5, r ? 0.f : 1.0f, mlate, smem);
      ctr_barrier(xb, bar_epoch);
    }
    if (layer + 1 < DEPTH) conv_mixer(P_, layer + 1, smem);
    for (int r = 0; r <= RP_NORM; ++r) { phase_norm(P_, layer, 2, 6, 7, mlate); ctr_barrier(xb, bar_epoch); }
    for (int r = 0; r <= RP_UP; ++r) { phase_ffn_up(P_, 1, mlate, smem); ctr_barrier(xb, bar_epoch); }
    for (int r = 0; r <= RP_DOWN; ++r) {
      phase_gemm_res(P_, layer, (const bf16_t*)(P_.ws + OFF_BIG), DFF, (const bf16_t*)(P_.ws + OFF_W2B), DFF, 8, r ? 0.f : 0.5f, mlate, smem);
      ctr_barrier(xb, bar_epoch);
    }
  }
}

extern "C" void kernel_launch(void* const* d_in, const int* in_sizes, int n_in, void* d_out, int out_size,
                              void* d_ws, size_t ws_size, hipStream_t stream) {
  static int grid_blocks = 0;
  if (!grid_blocks) {
    int dev = 0, cus = 0, per_cu = 0;
    (void)hipGetDevice(&dev);
    (void)hipDeviceGetAttribute(&cus, hipDeviceAttributeMultiprocessorCount, dev);
    (void)hipOccupancyMaxActiveBlocksPerMultiprocessor(&per_cu, fwd_megakernel, 512, 0);
    if (per_cu > 1) per_cu = 1;
    if (per_cu < 1) per_cu = 1;
    grid_blocks = cus * per_cu;
    if (ws_size < WS_NEED) fprintf(stderr, "workspace too small: %zu < %zu\n", ws_size, (size_t)WS_NEED);
  }
  Params p{};
  for (int i = 0; i < 30; ++i) p.in[i] = (const float*)d_in[i];
  p.out = (float*)d_out;
  p.ws = (unsigned char*)d_ws;
  void* args[] = {&p};
  hipError_t e = hipLaunchCooperativeKernel((void*)fwd_megakernel, dim3(grid_blocks), dim3(512), args, 0, stream);
  if (e != hipSuccess) fprintf(stderr, "cooperative launch failed: %s (grid %d)\n", hipGetErrorString(e), grid_blocks);
}
```

```cpp
#include <hip/hip_runtime.h>
#include <hip/hip_cooperative_groups.h>
#include <cstdio>
#include <cstdint>
namespace cg = cooperative_groups;

typedef unsigned short bf16_t;
typedef short bf16x8 __attribute__((ext_vector_type(8)));
typedef float f32x4 __attribute__((ext_vector_type(4)));
typedef float f32x16 __attribute__((ext_vector_type(16)));
typedef __bf16 bf2_t __attribute__((ext_vector_type(2)));
typedef float f2_t __attribute__((ext_vector_type(2)));
typedef unsigned u32x4 __attribute__((ext_vector_type(4)));
typedef unsigned u32x2 __attribute__((ext_vector_type(2)));
#define DI __device__ __forceinline__

constexpr int D = 1024, NB = 8, S = 4096, CL = 256, DEPTH = 4, DFF = 2816, INC = 2464, INCP = 2560;
constexpr int ML = NB * S, MC = NB * CL, MT = ML + MC, KEYS = S + CL;
constexpr float LOG2E = 1.4426950408889634f;
constexpr float EPS = 1e-6f;

constexpr size_t al256(size_t x) { return (x + 255) & ~(size_t)255; }
constexpr size_t OFF_XC = 0;
constexpr size_t OFF_MOD = OFF_XC + (size_t)MC * D * 4;
constexpr size_t OFF_CTRL = OFF_MOD + al256((size_t)DEPTH * 9 * 9216 * 4);
constexpr size_t OFF_H = OFF_CTRL + 4096;
constexpr size_t OFF_W13A = OFF_H + (size_t)MT * D * 2;
constexpr size_t OFF_W2A = OFF_W13A + (size_t)2 * DFF * D * 2;
constexpr size_t OFF_W13B = OFF_W2A + (size_t)D * DFF * 2;
constexpr size_t OFF_W2B = OFF_W13B + (size_t)2 * DFF * D * 2;
constexpr size_t OFF_WIN = OFF_W2B + (size_t)D * DFF * 2;
constexpr size_t OFF_WG = OFF_WIN + (size_t)INCP * D * 2;
constexpr size_t OFF_WB = OFF_WG + (size_t)4 * D * D * 2;
constexpr size_t OFF_WO = OFF_WB + (size_t)4 * D * 256 * 2;
constexpr size_t OFF_WUQ = OFF_WO + (size_t)D * D * 2;
constexpr size_t OFF_WUKV = OFF_WUQ + (size_t)384 * 256 * 2;
constexpr size_t OFF_BIG = OFF_WUKV + (size_t)512 * 128 * 2;
constexpr size_t OFF_Y = OFF_BIG + (size_t)MT * D * 2;
constexpr size_t OFF_QKV = OFF_BIG + (size_t)MT * DFF * 2;
constexpr size_t N_Q64K = (size_t)NB * 4 * KEYS * 64;
constexpr size_t N_Q64S = (size_t)NB * 4 * S * 64;
constexpr size_t OFF_NA_Q = OFF_QKV;
constexpr size_t OFF_NA_K = OFF_NA_Q + N_Q64K * 2;
constexpr size_t OFF_NA_VT = OFF_NA_K + N_Q64K * 2;
constexpr size_t OFF_G_QP = OFF_NA_VT + N_Q64K * 2;
constexpr size_t OFF_G_QN = OFF_G_QP + N_Q64S * 2;
constexpr size_t OFF_G_K = OFF_G_QN + N_Q64K * 2;
constexpr size_t OFF_G_VT = OFF_G_K + (size_t)NB * 2 * KEYS * 64 * 2;
constexpr size_t OFF_D_QP = OFF_G_VT + (size_t)NB * 2 * KEYS * 64 * 2;
constexpr size_t OFF_D_QN = OFF_D_QP + (size_t)NB * 8 * S * 32 * 2;
constexpr size_t OFF_D_K = OFF_D_QN + (size_t)NB * 8 * KEYS * 32 * 2;
constexpr size_t OFF_D_VT = OFF_D_K + (size_t)NB * 8 * KEYS * 32 * 2;
constexpr size_t OFF_M_QP = OFF_D_VT + N_Q64K * 2;
constexpr size_t OFF_M_QN = OFF_M_QP + (size_t)NB * 4 * S * 96 * 2;
constexpr size_t OFF_M_K = OFF_M_QN + (size_t)NB * 4 * KEYS * 96 * 2;
constexpr size_t OFF_M_VT = OFF_M_K + (size_t)NB * 4 * KEYS * 96 * 2;
constexpr size_t OFF_SCR = OFF_M_VT + N_Q64K * 2;
constexpr size_t OFF_BAR = OFF_SCR + (size_t)1024 * 8192 * 4;
constexpr size_t WS_NEED = OFF_BAR + 16384;

constexpr int LDS_BYTES = 131072;
constexpr int NTHR = 512, NWAVE = 8;

struct Params {
  const float* in[30];
  float* out;
  unsigned char* ws;
};
typedef const __attribute__((address_space(4))) Params& PR;
typedef const __attribute__((address_space(4))) Params* KP;

DI int tid() { int t = __builtin_amdgcn_workitem_id_x(); asm volatile("" : "+v"(t)); return t; }
DI float bf2f(bf16_t v) { return __uint_as_float(((unsigned)v) << 16); }
DI unsigned pk(float a, float b) { f2_t v = {a, b}; bf2_t r = __builtin_convertvector(v, bf2_t); return __builtin_bit_cast(unsigned, r); }
DI bf16_t f2bf(float a) { return (bf16_t)(pk(a, 0.f) & 0xffffu); }
DI float shx(float v, int mask) { return __int_as_float(__builtin_amdgcn_ds_bpermute(((tid() ^ mask) & 63) << 2, __float_as_int(v))); }
template <int CTRL> DI float dppf(float v) { return __int_as_float(__builtin_amdgcn_update_dpp(0, __float_as_int(v), CTRL, 0xF, 0xF, true)); }
DI float sum4(float v)  { v += dppf<0xB1>(v); v += dppf<0x4E>(v); return v; }
DI float sum8(float v)  { v = sum4(v); v += dppf<0x141>(v); return v; }
DI float sum16(float v) { v = sum8(v); v += dppf<0x140>(v); return v; }
DI float wsum64(float v) {
  v = sum16(v); v += shx(v, 16); v += shx(v, 32);
  return v;
}
DI float wsum32(float v) {
  v += shx(v, 16); v += shx(v, 8); v += shx(v, 4); v += shx(v, 2); v += shx(v, 1);
  return v;
}
DI float* xrow(PR p, int m) {
  return m < ML ? p.out + (size_t)m * D : (float*)(p.ws + OFF_XC) + (size_t)(m - ML) * D;
}
DI const float* xsrc(PR p, int m, bool first) {
  if (!first) return xrow(p, m);
  return m < ML ? p.in[0] + (size_t)m * D : p.in[2] + (size_t)(m - ML) * D;
}
DI const float* modrow(PR p, int layer, int m) {
  const int b = m < ML ? (m >> 12) : 8;
  return (const float*)(p.ws + OFF_MOD) + (size_t)(layer * 9 + b) * 9216;
}

DI int rowmap(int n, int mode) { return mode == 0 ? n : ((n >> 4) * 32 + (n & 15) + (mode == 2 ? 16 : 0)); }
DI void conv_job(const float* __restrict__ src, int K, int N, bf16_t* __restrict__ dst, int mode, unsigned char* smem, int rot) {
  const int tn = (N + 63) >> 6, ntile = (K >> 6) * tn, npair = (ntile + 1) >> 1;
  const int tf = tid(), half = tf >> 8, t = tf & 255;
  bf16_t* tl = (bf16_t*)smem + half * (64 * 66);
  const int G = gridDim.x;
  int start = (int)((blockIdx.x + G - (rot % G)) % G);
  for (int pu = start; pu < npair; pu += G) {
    const int u = pu * 2 + half;
    const bool act = u < ntile;
    const int k0 = (u / tn) << 6, n0 = (u % tn) << 6;
    __syncthreads();
    if (act) {
#pragma unroll
      for (int i = 0; i < 4; ++i) {
        const int kk = (t >> 4) + 16 * i, nn = (t & 15) * 4;
        if (n0 + nn < N) {
          const float4 v = *(const float4*)(src + (size_t)(k0 + kk) * N + n0 + nn);
          tl[(nn + 0) * 66 + kk] = f2bf(v.x); tl[(nn + 1) * 66 + kk] = f2bf(v.y);
          tl[(nn + 2) * 66 + kk] = f2bf(v.z); tl[(nn + 3) * 66 + kk] = f2bf(v.w);
        }
      }
    }
    __syncthreads();
    const int nl = t >> 2, part = t & 3, n = n0 + nl;
    if (act && n < N) {
      const unsigned* s32 = (const unsigned*)(tl + nl * 66 + part * 16);
      uint4 a, b;
      a.x = s32[0]; a.y = s32[1]; a.z = s32[2]; a.w = s32[3]; b.x = s32[4]; b.y = s32[5]; b.z = s32[6]; b.w = s32[7];
      uint4* d = (uint4*)(dst + (size_t)rowmap(n, mode) * K + k0 + part * 16);
      d[0] = a; d[1] = b;
    }
  }
}
DI void conv_ffn(PR p, int layer, int which, unsigned char* smem) {
  const size_t o = (size_t)(layer * 2 + which) * D * DFF;
  bf16_t* w13 = (bf16_t*)(p.ws + (which ? OFF_W13B : OFF_W13A));
  bf16_t* w2 = (bf16_t*)(p.ws + (which ? OFF_W2B : OFF_W2A));
  conv_job(p.in[7] + o, D, DFF, w13, 1, smem, 0);
  conv_job(p.in[8] + o, D, DFF, w13, 2, smem, 96);
  conv_job(p.in[9] + o, DFF, D, w2, 0, smem, 192);
}
DI void conv_mixer(PR p, int layer, unsigned char* smem) {
  conv_job(p.in[10] + (size_t)layer * D * INC, D, INC, (bf16_t*)(p.ws + OFF_WIN), 0, smem, 0);
  for (int j = 0; j < 4; ++j)
    conv_job(p.in[26] + (size_t)(layer * 4 + j) * D * D, D, D, (bf16_t*)(p.ws + OFF_WG) + (size_t)j * D * D, 0, smem, 20 + 64 * j);
  for (int j = 0; j < 4; ++j)
    conv_job(p.in[28] + (size_t)(layer * 4 + j) * 256 * D, 256, D, (bf16_t*)(p.ws + OFF_WB) + (size_t)j * D * 256, 0, smem, 20 + 32 * j);
  conv_job(p.in[29] + (size_t)layer * D * D, D, D, (bf16_t*)(p.ws + OFF_WO), 0, smem, 148);
  conv_job(p.in[22] + (size_t)layer * 256 * 384, 256, 384, (bf16_t*)(p.ws + OFF_WUQ), 0, smem, 212);
  conv_job(p.in[23] + (size_t)layer * 128 * 512, 128, 512, (bf16_t*)(p.ws + OFF_WUKV), 0, smem, 224);
}

DI void phase_prologue(PR p, unsigned char* smem) {
  const int t = tid(), lane = t & 63, wave = t >> 6;
  if (blockIdx.x == 0 && t < 256) ((int*)(p.ws + OFF_CTRL))[t] = 0;
  float* sl = (float*)smem;
  float* red = sl + 9 * 1024;
  for (int i = t; i < 9 * 1024; i += NTHR) {
    const int r = i >> 10, k = i & 1023;
    const float v = r < 8 ? p.in[1][r * 1024 + k] : p.in[3][k];
    sl[i] = v / (1.f + __expf(-v));
  }
  __syncthreads();
  for (int u = blockIdx.x; u < DEPTH * 144; u += gridDim.x) {
    const int l = u / 144, n0 = (u % 144) * 64;
    const float* w = p.in[4] + (size_t)l * 1024 * 9216 + n0 + lane;
    float acc[9];
#pragma unroll
    for (int r = 0; r < 9; ++r) acc[r] = 0.f;
    const int kb = wave * 128;
#pragma unroll 16
    for (int k = kb; k < kb + 128; ++k) {
      const float wv = w[(size_t)k * 9216];
#pragma unroll
      for (int r = 0; r < 9; ++r) acc[r] += sl[r * 1024 + k] * wv;
    }
#pragma unroll
    for (int r = 0; r < 9; ++r) red[(wave * 9 + r) * 64 + lane] = acc[r];
    __syncthreads();
    for (int i = t; i < 9 * 64; i += NTHR) {
      const int r = i >> 6, c = i & 63;
      float sum = 0.f;
#pragma unroll
      for (int w = 0; w < NWAVE; ++w) sum += red[(w * 9 + r) * 64 + c];
      ((float*)(p.ws + OFF_MOD))[(size_t)(l * 9 + r) * 9216 + n0 + c] = sum + p.in[5][l * 9216 + n0 + c];
    }
    __syncthreads();
  }
  conv_ffn(p, 0, 0, smem);
  conv_ffn(p, 0, 1, smem);
  conv_mixer(p, 0, smem);
}

DI void phase_norm(PR p, int layer, int which, int shift_idx, int scale_idx, int mrows, bool first = false) {
  const int lane = tid() & 63, wave = tid() >> 6;
  const float* g = p.in[6] + (size_t)(layer * 3 + which) * D;
  bf16_t* H = (bf16_t*)(p.ws + OFF_H);
  const int stride = gridDim.x * NWAVE;
  int row = blockIdx.x * NWAVE + wave;
  float4 v[4], nv[4];
  if (row < mrows) {
    const float4* xr = (const float4*)xsrc(p, row, first);
#pragma unroll
    for (int i = 0; i < 4; ++i) v[i] = xr[lane + 64 * i];
  }
  for (; row < mrows; row += stride) {
    const int nrow = row + stride;
    if (nrow < mrows) {
      const float4* xr = (const float4*)xsrc(p, nrow, first);
#pragma unroll
      for (int i = 0; i < 4; ++i) nv[i] = xr[lane + 64 * i];
    }
    const float* mod = modrow(p, layer, row);
    float ss = 0.f;
#pragma unroll
    for (int i = 0; i < 4; ++i) ss += v[i].x * v[i].x + v[i].y * v[i].y + v[i].z * v[i].z + v[i].w * v[i].w;
    ss = wsum64(ss);
    const float rstd = rsqrtf(ss * (1.f / 1024.f) + EPS);
#pragma unroll
    for (int i = 0; i < 4; ++i) {
      const int c = 4 * (lane + 64 * i);
      const float4 g4 = *(const float4*)(g + c), sc = *(const float4*)(mod + scale_idx * 1024 + c), sh = *(const float4*)(mod + shift_idx * 1024 + c);
      const float h0 = v[i].x * rstd * g4.x * (1.f + sc.x) + sh.x, h1 = v[i].y * rstd * g4.y * (1.f + sc.y) + sh.y;
      const float h2 = v[i].z * rstd * g4.z * (1.f + sc.z) + sh.z, h3 = v[i].w * rstd * g4.w * (1.f + sc.w) + sh.w;
      uint2 o; o.x = pk(h0, h1); o.y = pk(h2, h3);
      *(uint2*)(H + (size_t)row * D + c) = o;
    }
#pragma unroll
    for (int i = 0; i < 4; ++i) v[i] = nv[i];
  }
}

DI int lds_byte(int r, int c) {
  const int st = (r >> 4) * 2 + (c >> 5), ob = (r & 15) * 64 + (c & 31) * 2;
  return st * 1024 + (ob ^ (((ob >> 9) & 1) << 5));
}
DI void stage_rc(int b, int& R, int& C) {
  const int st = b >> 10, sb = b & 1023, swz = sb ^ (((sb >> 9) & 1) << 5);
  R = (st >> 1) * 16 + swz / 64;
  C = (st & 1) * 32 + (swz % 64) / 2;
}
#define WAIT_V0() asm volatile("s_waitcnt vmcnt(0)" ::: "memory")
constexpr int G_STAGE = 65536;

struct GSeg { const bf16_t* A; const bf16_t* Bt; int lda, ldb, nk, m0, n0; };
constexpr int PFD = 100000;
#define WAIT_V1() asm volatile("s_waitcnt vmcnt(1)" ::: "memory")

template <int MTW, int NTW = 4>
DI void gemm_mainloop(const GSeg& sg, const GSeg& nx, unsigned char* smem, f32x4 (&acc)[MTW][NTW]) {
  constexpr int GLA = MTW / 2, GLB = NTW;
  const int t = tid(), lane = t & 63, wid = t >> 6, wr = wid >> 2, wc = wid & 3, fr = lane & 15, fq = lane >> 4;
  const bf16_t* ga[GLA]; const bf16_t* gb[GLB];
#pragma unroll
  for (int i = 0; i < GLA; ++i) { int R, C; stage_rc(wid * 1024 + i * 8192 + lane * 16, R, C); ga[i] = sg.A + (size_t)(sg.m0 + R) * sg.lda + C; }
#pragma unroll
  for (int i = 0; i < GLB; ++i) { int R, C; stage_rc(wid * 1024 + i * 8192 + lane * 16, R, C); gb[i] = sg.Bt + (size_t)(sg.n0 + R) * sg.ldb + C; }
  const int prow = t < 256 ? min(t, MTW * 32 - 1) : t - 256;
  const bf16_t* pf_c = t < 256 ? sg.A + (size_t)(sg.m0 + prow) * sg.lda : sg.Bt + (size_t)(sg.n0 + prow) * sg.ldb;
  const bf16_t* pf_n = t < 256 ? nx.A + (size_t)(nx.m0 + prow) * nx.lda : nx.Bt + (size_t)(nx.n0 + prow) * nx.ldb;
  unsigned pfd = 0u;
#define G_STAGE_IN(buf, kt)                                                                                          \
  {                                                                                                                  \
    _Pragma("unroll") for (int i = 0; i < GLA; ++i)                                                                  \
      __builtin_amdgcn_global_load_lds((const unsigned*)(ga[i] + (kt) * 64), (unsigned*)(smem + (buf) * G_STAGE + wid * 1024 + i * 8192), 16, 0, 0); \
    _Pragma("unroll") for (int i = 0; i < GLB; ++i)                                                                  \
      __builtin_amdgcn_global_load_lds((const unsigned*)(gb[i] + (kt) * 64), (unsigned*)(smem + (buf) * G_STAGE + 32768 + wid * 1024 + i * 8192), 16, 0, 0); \
  }
  const int nk = sg.nk;
  G_STAGE_IN(0, 0);
  WAIT_V0();
  __syncthreads();
  if (nk > 1) G_STAGE_IN(1, 1);
#pragma unroll 1
  for (int kt = 0; kt < nk; ++kt) {
    const int cur = kt & 1;
    const int pj = kt + PFD;
    const bool pf_on = pj < nk || (pj - nk) < nx.nk;
    if (pf_on) {
      const bf16_t* pa = pj < nk ? pf_c + pj * 64 : pf_n + (pj - nk) * 64;
      asm volatile("global_load_dword %0, %1, off" : "+v"(pfd) : "v"(pa) : "memory");
    }
    const unsigned char* sa = smem + cur * G_STAGE;
    const unsigned char* sb = sa + 32768;
    bf16x8 At[MTW], Bf[NTW];
#pragma unroll
    for (int m = 0; m < MTW; ++m) At[m] = *(const bf16x8*)(sa + lds_byte(wr * (MTW * 16) + m * 16 + fr, fq * 8));
#pragma unroll
    for (int n = 0; n < NTW; ++n) Bf[n] = *(const bf16x8*)(sb + lds_byte(wc * (NTW * 16) + n * 16 + fr, fq * 8));
#pragma unroll
    for (int m = 0; m < MTW; ++m)
#pragma unroll
      for (int n = 0; n < NTW; ++n) acc[m][n] = __builtin_amdgcn_mfma_f32_16x16x32_bf16(Bf[n], At[m], acc[m][n], 0, 0, 0);
    bf16x8 At1[MTW], Bf1[NTW];
#pragma unroll
    for (int m = 0; m < MTW; ++m) At1[m] = *(const bf16x8*)(sa + lds_byte(wr * (MTW * 16) + m * 16 + fr, 32 + fq * 8));
#pragma unroll
    for (int n = 0; n < NTW; ++n) Bf1[n] = *(const bf16x8*)(sb + lds_byte(wc * (NTW * 16) + n * 16 + fr, 32 + fq * 8));
    if (pf_on) { WAIT_V1(); } else { WAIT_V0(); }
    __syncthreads();
    if (kt + 2 < nk) G_STAGE_IN(cur, kt + 2);
    __builtin_amdgcn_sched_barrier(0);
#pragma unroll
    for (int m = 0; m < MTW; ++m)
#pragma unroll
      for (int n = 0; n < NTW; ++n) acc[m][n] = __builtin_amdgcn_mfma_f32_16x16x32_bf16(Bf1[n], At1[m], acc[m][n], 0, 0, 0);
  }
  WAIT_V0();
  asm volatile("" :: "v"(pfd));
#undef G_STAGE_IN
}

#define PG8_LAS __attribute__((address_space(3)))
struct PG8Unit { int pm, pn; };
struct PG8Gemm { const bf16_t* A; const bf16_t* Bt; int lda, ldb, K; };
struct PG8Order {
  int ntiles, chunk, xcd, li, per, pm0;
  DI void init(int pm0_, int mtiles, int ntiles_) { pm0 = pm0_; ntiles = ntiles_; chunk = (mtiles * ntiles_) >> 3; xcd = blockIdx.x & 7; li = blockIdx.x >> 3; per = gridDim.x >> 3; }
  DI bool next(int i, PG8Unit& u) const {
    const int q = li + i * per; if (q >= chunk) return false;
    const int T = xcd * chunk + q, mg = T / (4 * ntiles), rem = T % (4 * ntiles);
    u.pm = pm0 + mg * 4 + (rem & 3); u.pn = rem >> 2; return true;
  }
};
#define Unit PG8Unit
template <class Epi, class Sched>
__device__ __forceinline__ void pg8_gemm_phase(PG8_LAS unsigned char* lds, const PG8Gemm g, const Sched& S, const Epi& E) {
    constexpr bool ALIGN_EPI = true, SP2 = true;
    constexpr int BK = 64, HALF = 128, HTB = HALF * BK * 2;
    const int tid = ::tid(), wid = __builtin_amdgcn_readfirstlane(tid >> 6), lane = tid & 63, wr = wid >> 2, wc = wid & 3, fr = lane & 15, fq = lane >> 4;
    const int K = g.K, nt = K / BK;
    unsigned voffA[2], voffB[2];
#pragma unroll
    for (int i = 0; i < 2; ++i) { int R, C; stage_rc(tid * 16 + i * 8192, R, C); const int Rb = R;
        voffA[i] = (unsigned)(R * g.lda + C) * 2u; voffB[i] = (unsigned)(Rb * g.ldb + C) * 2u; }
    const size_t kstep = (size_t)(BK * 2);
    const size_t hstepA = (size_t)HALF * g.lda * 2, hstepB = (size_t)HALF * g.ldb * 2;
    const size_t tstepA = 2 * hstepA, tstepB = 2 * hstepB;
    const unsigned ldsw = (unsigned)wid * 1024u;
    const int aoff = lds_byte(wr * 64 + fr, fq * 8), boff = lds_byte(wc * 32 + fr, fq * 8);
#define PG8_SA(b, h) (((b) * 2 + (h)) * HTB)
#define PG8_SB(b, h) ((4 + (b) * 2 + (h)) * HTB)
#define PG8_STAGE(bufoff, gbase, voff) do { _Pragma("unroll") for (int _i = 0; _i < 2; ++_i) \
        __builtin_amdgcn_global_load_lds((const unsigned*)((const char*)(gbase) + (voff)[_i]), (PG8_LAS unsigned*)(lds + (bufoff) + ldsw + _i * 8192), 16, 0, 0); } while (0)
#define PG8_LDA(dst, b, h) do { _Pragma("unroll") for (int m = 0; m < 4; ++m) _Pragma("unroll") for (int k = 0; k < 2; ++k) dst[m][k] = *(const PG8_LAS bf16x8*)(lds + PG8_SA(b, h) + aoff + m * 2048 + k * 1024); } while (0)
#define PG8_LDB(dst, b, h) do { _Pragma("unroll") for (int n = 0; n < 2; ++n) _Pragma("unroll") for (int k = 0; k < 2; ++k) dst[n][k] = *(const PG8_LAS bf16x8*)(lds + PG8_SB(b, h) + boff + n * 2048 + k * 1024); } while (0)
#define PG8_MMA(ai, bj, At, Bt) do { __builtin_amdgcn_s_setprio(1); _Pragma("unroll") for (int m = 0; m < 4; ++m) _Pragma("unroll") for (int n = 0; n < 2; ++n) _Pragma("unroll") for (int k = 0; k < 2; ++k) \
        acc[ai][bj][m][n] = __builtin_amdgcn_mfma_f32_16x16x32_bf16(Bt[n][k], At[m][k], acc[ai][bj][m][n], 0, 0, 0); __builtin_amdgcn_s_setprio(0); } while (0)
#define PG8_WAIT_V(n) asm volatile("s_waitcnt vmcnt(" #n ")" ::: "memory")
#define PG8_WAIT_L(n) asm volatile("s_waitcnt lgkmcnt(" #n ")" ::: "memory")
#define PG8_BAR __builtin_amdgcn_s_barrier()
#define PG8_SCHED __builtin_amdgcn_sched_barrier(0)
    Unit cur, nxt; int ui = 0;
    if (!S.next(0, cur)) return;
    f32x4 acc[2][2][4][2];
#pragma unroll
    for (int a = 0; a < 2; ++a)
#pragma unroll
        for (int b = 0; b < 2; ++b)
#pragma unroll
            for (int m = 0; m < 4; ++m)
#pragma unroll
                for (int n = 0; n < 2; ++n) acc[a][b][m][n] = (f32x4){0.f, 0.f, 0.f, 0.f};
    bf16x8 At[4][2], B0[2][2], B1[2][2];
    const char* cA = (const char*)g.A + (size_t)cur.pm * tstepA; const char* cB = (const char*)g.Bt + (size_t)cur.pn * tstepB;
    if constexpr (SP2) {
        PG8_STAGE(PG8_SB(0, 0), cB, voffB); PG8_STAGE(PG8_SB(0, 1), cB + hstepB, voffB); PG8_STAGE(PG8_SA(0, 0), cA, voffA); PG8_STAGE(PG8_SA(0, 1), cA + hstepA, voffA);
        if (wr == 1) PG8_BAR;
        PG8_WAIT_V(2); PG8_BAR;
        PG8_STAGE(PG8_SB(1, 0), cB + kstep, voffB); PG8_STAGE(PG8_SA(1, 0), cA + kstep, voffA); PG8_STAGE(PG8_SB(1, 1), cB + hstepB + kstep, voffB);
        PG8_WAIT_V(6); PG8_BAR;
    } else {
        PG8_STAGE(PG8_SB(0, 0), cB, voffB); PG8_STAGE(PG8_SA(0, 0), cA, voffA); PG8_STAGE(PG8_SB(0, 1), cB + hstepB, voffB); PG8_STAGE(PG8_SA(0, 1), cA + hstepA, voffA);
        if (wr == 1) PG8_BAR;
        PG8_WAIT_V(4); PG8_BAR;
        PG8_STAGE(PG8_SB(1, 0), cB + kstep, voffB); PG8_STAGE(PG8_SA(1, 0), cA + kstep, voffA); PG8_STAGE(PG8_SB(1, 1), cB + hstepB + kstep, voffB);
        PG8_WAIT_V(6); PG8_BAR;
    }
    for (;;) {
        const bool has_next = S.next(ui + 1, nxt);
        const char* nA = has_next ? (const char*)g.A + (size_t)nxt.pm * tstepA : cA; const char* nB = has_next ? (const char*)g.Bt + (size_t)nxt.pn * tstepB : cB;
        for (int t = 0; t < nt; t += 2) {
            const bool last = (t == nt - 2);
            const char* a1 = cA + (size_t)(t + 1) * kstep;
            const char* a2 = last ? nA : cA + (size_t)(t + 2) * kstep; const char* b2 = last ? nB : cB + (size_t)(t + 2) * kstep;
            const char* a3 = a2 + kstep; const char* b3 = b2 + kstep;

            if constexpr (SP2) {
            PG8_LDB(B0, 0, 0); PG8_LDB(B1, 0, 1); PG8_SCHED; PG8_LDA(At, 0, 0); PG8_STAGE(PG8_SA(1, 1), a1 + hstepA, voffA);
            PG8_WAIT_V(8); PG8_WAIT_L(0); PG8_BAR; PG8_MMA(0, 0, At, B0); PG8_MMA(0, 1, At, B1); PG8_BAR; PG8_SCHED;
            PG8_LDA(At, 0, 1); PG8_STAGE(PG8_SB(0, 0), b2, voffB); PG8_STAGE(PG8_SB(0, 1), b2 + hstepB, voffB); PG8_STAGE(PG8_SA(0, 0), a2, voffA);
            PG8_WAIT_V(8); PG8_WAIT_L(0); PG8_BAR; PG8_MMA(1, 0, At, B0); PG8_MMA(1, 1, At, B1); PG8_BAR; PG8_SCHED;
            PG8_LDB(B0, 1, 0); PG8_LDB(B1, 1, 1); PG8_SCHED; PG8_LDA(At, 1, 0); PG8_STAGE(PG8_SA(0, 1), a2 + hstepA, voffA);
            PG8_WAIT_V(8); PG8_WAIT_L(0); PG8_BAR; PG8_MMA(0, 0, At, B0); PG8_MMA(0, 1, At, B1); PG8_BAR; PG8_SCHED;
            PG8_LDA(At, 1, 1); PG8_STAGE(PG8_SB(1, 0), b3, voffB); PG8_STAGE(PG8_SB(1, 1), b3 + hstepB, voffB); PG8_STAGE(PG8_SA(1, 0), a3, voffA);
            PG8_WAIT_V(8); PG8_WAIT_L(0); PG8_BAR; PG8_MMA(1, 0, At, B0); PG8_MMA(1, 1, At, B1); PG8_BAR; PG8_SCHED;
            } else {
            PG8_LDB(B0, 0, 0); PG8_SCHED; PG8_LDA(At, 0, 0); PG8_STAGE(PG8_SA(1, 1), a1 + hstepA, voffA);
            PG8_WAIT_L(8); PG8_BAR; PG8_WAIT_L(0); PG8_MMA(0, 0, At, B0); PG8_BAR; PG8_SCHED;
            PG8_LDB(B1, 0, 1); PG8_STAGE(PG8_SB(0, 0), b2, voffB);
            PG8_BAR; PG8_WAIT_L(0); PG8_MMA(0, 1, At, B1); PG8_BAR;
            PG8_LDA(At, 0, 1); PG8_STAGE(PG8_SA(0, 0), a2, voffA);
            PG8_BAR; PG8_WAIT_L(0); PG8_MMA(1, 0, At, B0); PG8_BAR; PG8_SCHED;
            PG8_STAGE(PG8_SB(0, 1), b2 + hstepB, voffB);
            PG8_WAIT_V(6); PG8_BAR; PG8_MMA(1, 1, At, B1); PG8_BAR;
            PG8_LDB(B0, 1, 0); PG8_SCHED; PG8_LDA(At, 1, 0); PG8_STAGE(PG8_SA(0, 1), a2 + hstepA, voffA);
            PG8_WAIT_L(8); PG8_BAR; PG8_WAIT_L(0); PG8_MMA(0, 0, At, B0); PG8_BAR; PG8_SCHED;
            PG8_LDB(B1, 1, 1); PG8_STAGE(PG8_SB(1, 0), b3, voffB);
            PG8_BAR; PG8_WAIT_L(0); PG8_MMA(0, 1, At, B1); PG8_BAR;
            PG8_LDA(At, 1, 1); PG8_STAGE(PG8_SA(1, 0), a3, voffA);
            PG8_BAR; PG8_WAIT_L(0); PG8_MMA(1, 0, At, B0); PG8_BAR; PG8_SCHED;
            PG8_STAGE(PG8_SB(1, 1), b3 + hstepB, voffB);
            PG8_WAIT_V(6); PG8_BAR; PG8_MMA(1, 1, At, B1); PG8_BAR;
            }
        }
        if constexpr (ALIGN_EPI) { if (wr == 0) PG8_BAR; }
        E(acc, cur, wr, wc, fr, fq);
        if (!has_next) break;
#pragma unroll
        for (int a = 0; a < 2; ++a)
#pragma unroll
            for (int b = 0; b < 2; ++b)
#pragma unroll
                for (int m = 0; m < 4; ++m)
#pragma unroll
                    for (int n = 0; n < 2; ++n) acc[a][b][m][n] = (f32x4){0.f, 0.f, 0.f, 0.f};
        cur = nxt; cA = nA; cB = nB; ++ui;
        if constexpr (ALIGN_EPI) { if (wr == 1) PG8_BAR; }
    }
    PG8_WAIT_V(0);
    if constexpr (!ALIGN_EPI) { if (wr == 0) PG8_BAR; }
    PG8_BAR;

#undef PG8_SA
#undef PG8_SB
#undef PG8_STAGE
#undef PG8_LDA
#undef PG8_LDB
#undef PG8_MMA
#undef PG8_WAIT_V
#undef PG8_WAIT_L
#undef PG8_BAR
#undef PG8_SCHED
}
#undef Unit

template <int MTW, int NTW = 4, class Epi>
DI void gemm_phase(const bf16_t* A, int lda, const bf16_t* Bt, int ldb, int K, int mbase, int mtiles, int ntiles, unsigned char* smem, Epi epi) {
  const int total = mtiles * ntiles, chunk = total >> 3;
  const int xcd = blockIdx.x & 7, li = blockIdx.x >> 3, per = gridDim.x >> 3;
  const int lane = tid() & 63, wid = tid() >> 6, wr = wid >> 2, wc = wid & 3;
  for (int q = li; q < chunk; q += per) {
    const int T = xcd * chunk + q;
    const int mg = T / (8 * ntiles), rem = T % (8 * ntiles);
    const int m0 = mbase + (mg * 8 + (rem & 7)) * (MTW * 32), n0 = (rem >> 3) * (NTW * 64);
    f32x4 acc[MTW][NTW];
#pragma unroll
    for (int i = 0; i < MTW; ++i)
#pragma unroll
      for (int j = 0; j < NTW; ++j) acc[i][j] = (f32x4){0.f, 0.f, 0.f, 0.f};
    GSeg sg{A, Bt, lda, ldb, K >> 6, m0, n0}, nx{A, Bt, lda, ldb, 0, m0, n0};
    if (q + per < chunk) {
      const int T2 = T + per, mg2 = T2 / (8 * ntiles), rem2 = T2 % (8 * ntiles);
      nx.nk = K >> 6; nx.m0 = mbase + (mg2 * 8 + (rem2 & 7)) * (MTW * 32); nx.n0 = (rem2 >> 3) * (NTW * 64);
    }
    gemm_mainloop<MTW, NTW>(sg, nx, smem, acc);
    epi(acc, m0 + wr * (MTW * 16) + (lane & 15), n0 + wc * (NTW * 16) + 4 * (lane >> 4));
  }
}

DI void phase_ffn_up(PR p, int which, int mrows, unsigned char* smem) {
  const bf16_t* H = (const bf16_t*)(p.ws + OFF_H);
  const bf16_t* W = (const bf16_t*)(p.ws + (which ? OFF_W13B : OFF_W13A));
  bf16_t* U = (bf16_t*)(p.ws + OFF_BIG);
  PG8Order S; S.init(0, mrows / 256, 2 * DFF / 256);
  const PG8Gemm g{H, W, D, D, D};
  pg8_gemm_phase((PG8_LAS unsigned char*)smem, g, S, [&](const f32x4 (&acc)[2][2][4][2], const PG8Unit& u, int wr, int wc, int fr, int fq) {
    const int row0 = u.pm * 256 + wr * 64 + fr;
    const int j0 = ((u.pn * 256 + wc * 32) >> 1) + 4 * fq;
#pragma unroll
    for (int ai = 0; ai < 2; ++ai)
#pragma unroll
      for (int m = 0; m < 4; ++m) {
        bf16_t* ur = U + (size_t)(row0 + ai * 128 + m * 16) * DFF + j0;
#pragma unroll
        for (int bj = 0; bj < 2; ++bj) {
          float o[4];
#pragma unroll
          for (int e = 0; e < 4; ++e) { const float a = acc[ai][bj][m][0][e], b = acc[ai][bj][m][1][e]; o[e] = a * __builtin_amdgcn_rcpf(1.f + __expf(-a)) * b; }
          uint2 v; v.x = pk(o[0], o[1]); v.y = pk(o[2], o[3]);
          *(uint2*)(ur + bj * 64) = v;
        }
      }
  });
}
DI void phase_gemm_res(PR p, int layer, const bf16_t* A, int lda, const bf16_t* W, int K, int modidx, float coef, int mrows, unsigned char* smem, bool first = false) {
  auto epi = [&](auto& acc, int row0, int col0) {
    constexpr int MTW = sizeof(acc) / sizeof(acc[0]), NTW = sizeof(acc[0]) / sizeof(acc[0][0]);
    const float* gv = modrow(p, layer, row0) + modidx * 1024 + col0;
    float4 g4[NTW];
#pragma unroll
    for (int nt = 0; nt < NTW; ++nt) { g4[nt] = *(const float4*)(gv + 16 * nt); g4[nt].x *= coef; g4[nt].y *= coef; g4[nt].z *= coef; g4[nt].w *= coef; }
#pragma unroll
    for (int mt = 0; mt < MTW; ++mt) {
      float* xr = xrow(p, row0 + 16 * mt) + col0;
      const float* xs = xsrc(p, row0 + 16 * mt, first) + col0;
#pragma unroll
      for (int nt = 0; nt < NTW; ++nt) {
        float4 x = *(const float4*)(xs + 16 * nt);
        x.x += g4[nt].x * acc[mt][nt][0]; x.y += g4[nt].y * acc[mt][nt][1]; x.z += g4[nt].z * acc[mt][nt][2]; x.w += g4[nt].w * acc[mt][nt][3];
        *(float4*)(xr + 16 * nt) = x;
      }
    }
  };
  {
    PG8Order S; S.init(0, ML / 256, D / 256);
    const PG8Gemm g{A, W, lda, K, K};
    pg8_gemm_phase((PG8_LAS unsigned char*)smem, g, S, [&](const f32x4 (&acc)[2][2][4][2], const PG8Unit& u, int wr, int wc, int fr, int fq) {
      const int row0 = u.pm * 256 + wr * 64 + fr, col0 = u.pn * 256 + wc * 32 + 4 * fq;
      const float* gv = modrow(p, layer, row0) + modidx * 1024 + col0;
      float4 g4[2][2];
#pragma unroll
      for (int bj = 0; bj < 2; ++bj)
#pragma unroll
        for (int n = 0; n < 2; ++n) { g4[bj][n] = *(const float4*)(gv + bj * 128 + n * 16); g4[bj][n].x *= coef; g4[bj][n].y *= coef; g4[bj][n].z *= coef; g4[bj][n].w *= coef; }
#pragma unroll
      for (int ai = 0; ai < 2; ++ai)
#pragma unroll
        for (int m = 0; m < 4; ++m) {
          float* xr = xrow(p, row0 + ai * 128 + m * 16) + col0;
          const float* xs = xsrc(p, row0 + ai * 128 + m * 16, first) + col0;
#pragma unroll
          for (int bj = 0; bj < 2; ++bj)
#pragma unroll
            for (int n = 0; n < 2; ++n) {
              float4 x = *(const float4*)(xs + bj * 128 + n * 16);
              x.x += g4[bj][n].x * acc[ai][bj][m][n][0]; x.y += g4[bj][n].y * acc[ai][bj][m][n][1];
              x.z += g4[bj][n].z * acc[ai][bj][m][n][2]; x.w += g4[bj][n].w * acc[ai][bj][m][n][3];
              *(float4*)(xr + bj * 128 + n * 16) = x;
            }
        }
    });
  }
  if (mrows > ML) gemm_phase<2, 2>(A, lda, W, K, K, ML, MC / 64, D / 128, smem, epi);
}

DI void phase_win(PR p, unsigned char* smem) {
  bf16_t* P = (bf16_t*)(p.ws + OFF_BIG);
  PG8Order S; S.init(0, ML / 256, INCP / 256);
  const PG8Gemm g{(const bf16_t*)(p.ws + OFF_H), (const bf16_t*)(p.ws + OFF_WIN), D, D, D};
  pg8_gemm_phase((PG8_LAS unsigned char*)smem, g, S, [&](const f32x4 (&acc)[2][2][4][2], const PG8Unit& u, int wr, int wc, int fr, int fq) {
    const int row0 = u.pm * 256 + wr * 64 + fr, col0 = u.pn * 256 + wc * 32 + 4 * fq;
#pragma unroll
    for (int ai = 0; ai < 2; ++ai)
#pragma unroll
      for (int m = 0; m < 4; ++m) {
        bf16_t* pr = P + (size_t)(row0 + ai * 128 + m * 16) * INCP + col0;
#pragma unroll
        for (int bj = 0; bj < 2; ++bj)
#pragma unroll
          for (int n = 0; n < 2; ++n)
            if (col0 + bj * 128 + n * 16 < INC) {
              uint2 v; v.x = pk(acc[ai][bj][m][n][0], acc[ai][bj][m][n][1]); v.y = pk(acc[ai][bj][m][n][2], acc[ai][bj][m][n][3]);
              *(uint2*)(pr + bj * 128 + n * 16) = v;
            }
      }
  });
  gemm_phase<2, 2>((const bf16_t*)(p.ws + OFF_H), D, (const bf16_t*)(p.ws + OFF_WIN), D, D, ML, MC / 64, INCP / 128, smem, [&](auto& acc, int row0, int col0) {
#pragma unroll
    for (int mt = 0; mt < 2; ++mt) {
      bf16_t* pr = P + (size_t)(row0 + 16 * mt) * INCP + col0;
#pragma unroll
      for (int nt = 0; nt < 2; ++nt)
        if (col0 + 16 * nt < INC) { uint2 v; v.x = pk(acc[mt][nt][0], acc[mt][nt][1]); v.y = pk(acc[mt][nt][2], acc[mt][nt][3]); *(uint2*)(pr + 16 * nt) = v; }
    }
  });
}
DI void phase_mla_up(PR p, unsigned char* smem) {
  const bf16_t* P = (const bf16_t*)(p.ws + OFF_BIG);
  float* Pf = (float*)(p.ws + OFF_BIG);
  auto epi_q = [&](f32x4 (&acc)[4][4], int row0, int col0) {
#pragma unroll
    for (int mt = 0; mt < 4; ++mt)
#pragma unroll
      for (int nt = 0; nt < 4; ++nt)
        if (col0 + 16 * nt < 384) *(f32x4*)(Pf + (size_t)(row0 + 16 * mt) * (INCP / 2) + col0 + 16 * nt) = acc[mt][nt];
  };
  gemm_phase<4>(P + 2048, INCP, (const bf16_t*)(p.ws + OFF_WUQ), 256, 256, 0, MT / 128, 2, smem, epi_q);
  auto epi_kv = [&](f32x4 (&acc)[4][4], int row0, int col0) {
#pragma unroll
    for (int mt = 0; mt < 4; ++mt)
#pragma unroll
      for (int nt = 0; nt < 4; ++nt) *(f32x4*)(Pf + (size_t)(row0 + 16 * mt) * (INCP / 2) + 384 + col0 + 16 * nt) = acc[mt][nt];
  };
  gemm_phase<4>(P + 2304, INCP, (const bf16_t*)(p.ws + OFF_WUKV), 128, 128, 0, MT / 128, 2, smem, epi_kv);
}

constexpr int VS = 34;
DI void write_vt_rows(const bf16_t* vt, int nrows, int b, int tok0, bf16_t* dst0, int heads0, int r0) {
  for (int c = tid(); c < nrows * 4; c += NTHR) {
    const int r = c >> 2, part = c & 3;
    const unsigned* s = (const unsigned*)(vt + (r0 + r) * VS + (part >> 1) * 16 + (part & 1) * 4);
    uint4 v; v.x = s[0]; v.y = s[1]; v.z = s[4]; v.w = s[5];
    *(uint4*)(dst0 + ((size_t)(b * heads0 + (r >> 6)) * 64 + (r & 63)) * KEYS + tok0 + part * 8) = v;
  }
}
DI void unpack8(const u32x4& w, float (&x)[8]) {
#pragma unroll
  for (int k = 0; k < 4; ++k) { x[2 * k] = __uint_as_float(w[k] << 16); x[2 * k + 1] = __uint_as_float(w[k] & 0xffff0000u); }
}
DI u32x4 pack8f(const float (&x)[8]) {
  u32x4 r;
#pragma unroll
  for (int k = 0; k < 4; ++k) r[k] = pk(x[2 * k], x[2 * k + 1]);
  return r;
}
DI void load8f(const float* g, float (&x)[8]) {
  const float4 a = *(const float4*)g, b = *(const float4*)(g + 4);
  x[0] = a.x; x[1] = a.y; x[2] = a.z; x[3] = a.w; x[4] = b.x; x[5] = b.y; x[6] = b.z; x[7] = b.w;
}
template <int PX>
DI void rope8(const float (&x)[8], float (&y)[8], const float2* T, float sgn) {
#pragma unroll
  for (int i = 0; i < 8; ++i) {
    const float pv = dppf<(PX == 1 ? 0xB1 : 0x4E)>(x[i]);
    const float2 cs = T[i];
    y[i] = x[i] * cs.x + sgn * pv * cs.y;
  }
}
constexpr int QK_T64 = 45056, QK_T32 = QK_T64 + 8192;
DI void phase_qkv(PR p, int layer, unsigned char* smem) {
  const int t = tid(), lane = t & 63, wave = t >> 6;
  bf16_t* P = (bf16_t*)(p.ws + OFF_BIG);
  bf16_t* vt = (bf16_t*)smem;
  float2* T64 = (float2*)(smem + QK_T64);
  float2* T32 = (float2*)(smem + QK_T32);
  if (blockIdx.x == 0 && t == 0) {
    const float* lv = p.in[18] + layer * 128;
    float a = 0.f, b = 0.f;
    for (int i = 0; i < 32; ++i) { a += lv[i] * lv[32 + i]; b += lv[64 + i] * lv[96 + i]; }
    const float lam_init = 0.8f - 0.6f * expf(-0.3f * (float)layer);
    ((float*)(p.ws + OFF_CTRL))[512 + layer] = expf(a) - expf(b) + lam_init;
  }
  for (int i = t; i < 1024; i += NTHR) {
    float sn, cs; sincosf((float)(i >> 4) * exp2f(-(float)(i & 15) * (13.287712379549449f / 16.f)), &sn, &cs);
    T64[i] = make_float2(cs, sn);
  }
  for (int i = t; i < 512; i += NTHR) {
    float sn, cs; sincosf((float)(i >> 3) * exp2f(-(float)(i & 7) * (13.287712379549449f / 8.f)), &sn, &cs);
    T32[i] = make_float2(cs, sn);
  }
  const int d8 = (lane & 7) * 8, e8 = (lane & 3) * 8;
  float g0[8], g1[8], g2[8], g3[8], g4[8];
  load8f((lane < 32 ? p.in[11] : p.in[12]) + layer * 64 + d8, g0);
  load8f(p.in[14] + layer * 64 + d8, g1);
  load8f(lane < 32 ? p.in[15] + layer * 64 + d8 : p.in[16] + layer * 32 + e8, g2);
  load8f(p.in[17] + layer * 32 + e8, g3);
  load8f(lane < 32 ? p.in[20] + layer * 256 + 8 * lane : p.in[21] + layer * 128 + 8 * (lane & 15), g4);
  const float sc64 = 0.125f * LOG2E, sc32 = 0.17677669529663687f * LOG2E;
  const float sg64 = (lane & 2) ? 1.f : -1.f, sg32 = (lane & 1) ? 1.f : -1.f;
  bf16_t* naQ = (bf16_t*)(p.ws + OFF_NA_Q); bf16_t* naK = (bf16_t*)(p.ws + OFF_NA_K);
  bf16_t* gQp = (bf16_t*)(p.ws + OFF_G_QP); bf16_t* gQn = (bf16_t*)(p.ws + OFF_G_QN); bf16_t* gK = (bf16_t*)(p.ws + OFF_G_K);
  bf16_t* dQp = (bf16_t*)(p.ws + OFF_D_QP); bf16_t* dQn = (bf16_t*)(p.ws + OFF_D_QN); bf16_t* dK = (bf16_t*)(p.ws + OFF_D_K);
  for (int unit = blockIdx.x; unit < MT / 32; unit += gridDim.x) {
    const int m0 = unit * 32;
    const bool isc = m0 >= ML;
    const int b = isc ? ((m0 - ML) >> 8) : (m0 >> 12);
    const int pos0 = isc ? ((m0 - ML) & 255) : (m0 & 4095);
    const int tok0 = isc ? (S + pos0) : pos0;
    u32x4 w[4][5];
#pragma unroll
    for (int tt = 0; tt < 4; ++tt)
#pragma unroll
      for (int j = 0; j < 5; ++j) {
        if (j < 4 || lane < 52) w[tt][j] = *(const u32x4*)(P + (size_t)(m0 + wave * 4 + tt) * INCP + 512 * j + 8 * lane);
        else w[tt][j] = (u32x4){0u, 0u, 0u, 0u};
      }
    __syncthreads();
#pragma unroll
    for (int tt = 0; tt < 4; ++tt) {
      const int tl = wave * 4 + tt, m = m0 + tl, pos = pos0 + tl, tok = tok0 + tl;
      const int prow = (pos >> 6) & 63, pcol = pos & 63;
      const float2* t64 = T64 + ((lane & 4) ? pcol : prow) * 16 + (lane & 1) * 8;
      const float2* t32 = T32 + ((lane & 2) ? pcol : prow) * 8;
      float x[8], y[8];
      float ss, s4, s8, r;
      unpack8(w[tt][0], x);
      ss = 0.f;
#pragma unroll
      for (int i = 0; i < 8; ++i) ss += x[i] * x[i];
      ss = sum8(ss);
      r = rsqrtf(ss * (1.f / 64.f) + EPS) * (lane < 32 ? sc64 : 1.f);
#pragma unroll
      for (int i = 0; i < 8; ++i) x[i] *= r * g0[i];
      *(u32x4*)((lane < 32 ? naQ : naK) + ((size_t)(b * 4 + ((lane >> 3) & 3)) * KEYS + tok) * 64 + d8) = pack8f(x);
      unpack8(w[tt][1], x);
      if (lane < 32) {
#pragma unroll
        for (int i = 0; i < 8; ++i) vt[((lane >> 3) * 64 + d8 + i) * VS + tl] = (bf16_t)(w[tt][1][i >> 1] >> (16 * (i & 1)));
      }
      ss = 0.f;
#pragma unroll
      for (int i = 0; i < 8; ++i) ss += x[i] * x[i];
      ss = sum8(ss);
      r = rsqrtf(ss * (1.f / 64.f) + EPS) * sc64;
#pragma unroll
      for (int i = 0; i < 8; ++i) x[i] *= r * g1[i];
      if (lane >= 32) *(u32x4*)(gQn + ((size_t)(b * 4 + (lane >> 3) - 4) * KEYS + tok) * 64 + d8) = pack8f(x);
      if (!isc) {
        rope8<2>(x, y, t64, sg64);
        if (lane >= 32) *(u32x4*)(gQp + ((size_t)(b * 4 + (lane >> 3) - 4) * S + pos) * 64 + d8) = pack8f(y);
      }
      unpack8(w[tt][2], x);
      if (lane >= 16 && lane < 32) {
#pragma unroll
        for (int i = 0; i < 8; ++i) vt[(256 + ((lane >> 3) - 2) * 64 + d8 + i) * VS + tl] = (bf16_t)(w[tt][2][i >> 1] >> (16 * (i & 1)));
      }
      ss = 0.f;
#pragma unroll
      for (int i = 0; i < 8; ++i) ss += x[i] * x[i];
      s4 = sum4(ss); s8 = s4 + dppf<0x141>(s4);
      r = lane < 32 ? rsqrtf(s8 * (1.f / 64.f) + EPS) : rsqrtf(s4 * (1.f / 32.f) + EPS) * sc32;
#pragma unroll
      for (int i = 0; i < 8; ++i) x[i] *= r * g2[i];
      if (lane >= 32) *(u32x4*)(dQn + ((size_t)(b * 8 + ((lane - 32) >> 2)) * KEYS + tok) * 32 + e8) = pack8f(x);
      if (!isc) {
        rope8<1>(x, y, t32, sg32);
        if (lane >= 32) *(u32x4*)(dQp + ((size_t)(b * 8 + ((lane - 32) >> 2)) * S + pos) * 32 + e8) = pack8f(y);
        rope8<2>(x, y, t64, sg64);
        if (lane < 16) *(u32x4*)(gK + ((size_t)(b * 2 + (lane >> 3)) * KEYS + tok) * 64 + d8) = pack8f(y);
      } else {
        if (lane < 16) *(u32x4*)(gK + ((size_t)(b * 2 + (lane >> 3)) * KEYS + tok) * 64 + d8) = pack8f(x);
      }
      unpack8(w[tt][3], x);
      if (lane >= 32) {
#pragma unroll
        for (int i = 0; i < 8; ++i) vt[(384 + ((lane - 32) >> 3) * 64 + d8 + i) * VS + tl] = (bf16_t)(w[tt][3][i >> 1] >> (16 * (i & 1)));
      }
      ss = 0.f;
#pragma unroll
      for (int i = 0; i < 8; ++i) ss += x[i] * x[i];
      s4 = sum4(ss);
      r = rsqrtf(s4 * (1.f / 32.f) + EPS);
#pragma unroll
      for (int i = 0; i < 8; ++i) x[i] *= r * g3[i];
      if (!isc) {
        rope8<1>(x, y, t32, sg32);
        if (lane < 32) *(u32x4*)(dK + ((size_t)(b * 8 + (lane >> 2)) * KEYS + tok) * 32 + e8) = pack8f(y);
      } else {
        if (lane < 32) *(u32x4*)(dK + ((size_t)(b * 8 + (lane >> 2)) * KEYS + tok) * 32 + e8) = pack8f(x);
      }
      unpack8(w[tt][4], x);
      ss = 0.f;
#pragma unroll
      for (int i = 0; i < 8; ++i) ss += x[i] * x[i];
      ss = sum16(ss);
      s8 = ss + shx(ss, 16);
      r = lane < 32 ? rsqrtf(s8 * (1.f / 256.f) + EPS) : rsqrtf(ss * (1.f / 128.f) + EPS);
#pragma unroll
      for (int i = 0; i < 8; ++i) x[i] *= r * g4[i];
      if (lane < 48) *(u32x4*)(P + (size_t)m * INCP + 2048 + 8 * lane) = pack8f(x);
    }
    __syncthreads();
    write_vt_rows(vt, 256, b, tok0, (bf16_t*)(p.ws + OFF_NA_VT), 4, 0);
    write_vt_rows(vt, 128, b, tok0, (bf16_t*)(p.ws + OFF_G_VT), 2, 256);
    write_vt_rows(vt, 256, b, tok0, (bf16_t*)(p.ws + OFF_D_VT), 4, 384);
  }
}

DI void phase_mla_post(PR p, int layer, unsigned char* smem) {
  const int t = tid(), lane = t & 63, wave = t >> 6, e = lane & 31;
  const bf16_t* P = (const bf16_t*)(p.ws + OFF_BIG);
  const float* Pf = (const float*)(p.ws + OFF_BIG);
  bf16_t* vt = (bf16_t*)smem;
  const float gq0 = p.in[24][layer * 96 + lane], gq1 = p.in[24][layer * 96 + 64 + e];
  const float gk0 = p.in[25][layer * 96 + lane], gk1 = p.in[25][layer * 96 + 64 + e];
  const float inv32 = exp2f(-(float)(lane & 7) * (13.287712379549449f / 8.f));
  const float sg32 = (lane & 8) ? 1.f : -1.f;
  const float sc96 = 0.10206207261596575f * LOG2E;
  bf16_t* mQp = (bf16_t*)(p.ws + OFF_M_QP); bf16_t* mQn = (bf16_t*)(p.ws + OFF_M_QN); bf16_t* mK = (bf16_t*)(p.ws + OFF_M_K);
  for (int unit = blockIdx.x; unit < MT / 32; unit += gridDim.x) {
    const int m0 = unit * 32;
    const bool isc = m0 >= ML;
    const int b = isc ? ((m0 - ML) >> 8) : (m0 >> 12);
    const int pos0 = isc ? ((m0 - ML) & 255) : (m0 & 4095);
    const int tok0 = isc ? (S + pos0) : pos0;
    float rq0[4][4], rq1[4][4], rk0[4][4], rvv[4][4], rkr[4];
#pragma unroll
    for (int tt = 0; tt < 4; ++tt) {
      const int m = m0 + wave * 4 + tt;
      const float* qraw = Pf + (size_t)m * (INCP / 2);
      rkr[tt] = lane < 32 ? bf2f(P[(size_t)m * INCP + 2432 + e]) : 0.f;
#pragma unroll
      for (int h = 0; h < 4; ++h) {
        rq0[tt][h] = qraw[h * 96 + lane];
        rq1[tt][h] = lane < 32 ? qraw[h * 96 + 64 + e] : 0.f;
        rk0[tt][h] = qraw[384 + h * 128 + lane];
        rvv[tt][h] = qraw[384 + h * 128 + 64 + lane];
      }
    }
    __syncthreads();
#pragma unroll
    for (int tt = 0; tt < 4; ++tt) {
      const int tl = wave * 4 + tt, pos = pos0 + tl, tok = tok0 + tl;
      float c32 = 1.f, s32 = 0.f;
      if (!isc) {
        const float frow = (float)(pos >> 6), fcol = (float)(pos & 63);
        sincosf(((lane & 16) ? fcol : frow) * inv32, &s32, &c32);
      }
      const float krp = rkr[tt];
#pragma unroll
      for (int h = 0; h < 4; ++h) {
        float q0 = rq0[tt][h], q1 = rq1[tt][h];
        float rs = rsqrtf(wsum64(q0 * q0 + q1 * q1) * (1.f / 96.f) + EPS);
        q0 = q0 * rs * gq0 * sc96; q1 = q1 * rs * gq1 * sc96;
        bf16_t* qn = mQn + ((size_t)(b * 4 + h) * KEYS + tok) * 96;
        qn[lane] = f2bf(q0);
        if (lane < 32) qn[64 + e] = f2bf(q1);
        if (!isc) {
          const float q1r = q1 * c32 + sg32 * dppf<0x128>(q1) * s32;
          bf16_t* qp = mQp + ((size_t)(b * 4 + h) * S + pos) * 96;
          qp[lane] = f2bf(q0);
          if (lane < 32) qp[64 + e] = f2bf(q1r);
        }
        float k0 = rk0[tt][h], k1 = krp;
        rs = rsqrtf(wsum64(k0 * k0 + k1 * k1) * (1.f / 96.f) + EPS);
        k0 = k0 * rs * gk0; k1 = k1 * rs * gk1;
        if (!isc) k1 = k1 * c32 + sg32 * dppf<0x128>(k1) * s32;
        bf16_t* kk = mK + ((size_t)(b * 4 + h) * KEYS + tok) * 96;
        kk[lane] = f2bf(k0);
        if (lane < 32) kk[64 + e] = f2bf(k1);
        vt[(h * 64 + lane) * VS + tl] = f2bf(rvv[tt][h]);
      }
    }
    __syncthreads();
    write_vt_rows(vt, 256, b, tok0, (bf16_t*)(p.ws + OFF_M_VT), 4, 0);
  }
}

constexpr int A_KBUF = 64 * 208, A_VBUF = 64 * 144, VSTR = 144;
constexpr int A_RPB = 2 * A_KBUF + 2 * A_VBUF;
constexpr int A_UNIT = A_RPB + 2048;

DI bf16x8 pack8(const f32x16& x, int s8) {
  u32x4 u;
  u.x = pk(x[s8 + 0], x[s8 + 1]); u.y = pk(x[s8 + 2], x[s8 + 3]); u.z = pk(x[s8 + 4], x[s8 + 5]); u.w = pk(x[s8 + 6], x[s8 + 7]);
  return __builtin_bit_cast(bf16x8, u);
}

template <int DK, bool NAM>
DI void attn_segment(const bf16x8 (&qf)[DK / 16], const bf16_t* __restrict__ Kg, const bf16_t* __restrict__ Vg, int ntiles, unsigned char* smem,
                     f32x16 (&ot)[2], float& m_run, f32x16& lsum, int qr, int qc, int key0, const float* rpb_l) {
  constexpr int KSTR = DK * 2 + 16, KCH = DK / 8, NKC = (64 * KCH + NTHR - 1) / NTHR;
  const int t = tid(), lane = t & 63, l31 = lane & 31, h = lane >> 5;
  u32x4 rk0[NKC], rk1[NKC], rv0, rv1;
  const int r0 = min(max(qr - 4, 0), 56), c0 = min(max(qc - 8, 0), 48);
  const bf16x8 ones = {16256, 16256, 16256, 16256, 16256, 16256, 16256, 16256};
  f32x16 zero16;
#pragma unroll
  for (int i = 0; i < 16; ++i) zero16[i] = 0.f;
#define ATT_LOADK(it, RK)                                                                                          \
  {                                                                                                                \
    const u32x4* ks = (const u32x4*)(Kg + (size_t)(it) * 64 * DK);                                                 \
    _Pragma("unroll") for (int i = 0; i < NKC; ++i) {                                                              \
      const int c = t + NTHR * i;                                                                                  \
      if (c < 64 * KCH) RK[i] = ks[c];                                                                             \
    }                                                                                                              \
  }
#define ATT_LOADV(it, RV) { RV = *(const u32x4*)(Vg + (size_t)(t >> 3) * KEYS + (it) * 64 + (t & 7) * 8); }
#define ATT_STOREK(buf, RK)                                                                                        \
  {                                                                                                                \
    unsigned char* kb_ = smem + (buf) * A_KBUF;                                                                    \
    _Pragma("unroll") for (int i = 0; i < NKC; ++i) {                                                              \
      const int c = t + NTHR * i;                                                                                  \
      if (c < 64 * KCH) *(u32x4*)(kb_ + (c / KCH) * KSTR + (c % KCH) * 16) = RK[i];                                \
    }                                                                                                              \
  }
#define ATT_STOREV(buf, RV)                                                                                        \
  {                                                                                                                \
    *(u32x4*)(smem + 2 * A_KBUF + (buf) * A_VBUF + (t >> 3) * VSTR + (t & 7) * 16) = RV;                           \
  }
#define ATT_QK(buf)                                                                                                \
  {                                                                                                                \
    const unsigned char* kb_ = smem + (buf) * A_KBUF;                                                              \
    _Pragma("unroll") for (int tt = 0; tt < 2; ++tt)                                                               \
      _Pragma("unroll") for (int s = 0; s < DK / 16; ++s) {                                                        \
        const bf16x8 kf = *(const bf16x8*)(kb_ + (32 * tt + l31) * KSTR + (16 * s + 8 * h) * 2);                   \
        st[tt] = __builtin_amdgcn_mfma_f32_32x32x16_bf16(kf, qf[s], s == 0 ? zero16 : st[tt], 0, 0, 0);            \
      }                                                                                                            \
  }
#define ATT_PV(buf) { ATT_PVH(buf, 0); ATT_PVH(buf, 1); }
#define ATT_PVH(buf, tt)                                                                                           \
  {                                                                                                                \
    const unsigned char* vb_ = smem + 2 * A_KBUF + (buf) * A_VBUF;                                                 \
      _Pragma("unroll") for (int s = 0; s < 2; ++s) {                                                              \
        lsum = __builtin_amdgcn_mfma_f32_32x32x16_bf16(ones, pf[tt][s], lsum, 0, 0, 0);                            \
        _Pragma("unroll") for (int d = 0; d < 2; ++d) {                                                            \
          const bf16x8 vf = *(const bf16x8*)(vb_ + (32 * d + l31) * VSTR + (32 * tt + 16 * s + 8 * h) * 2);        \
          ot[d] = __builtin_amdgcn_mfma_f32_32x32x16_bf16(vf, pf[tt][s], ot[d], 0, 0, 0);                          \
        }                                                                                                          \
      }                                                                                                            \
  }
  ATT_LOADK(0, rk0);
  ATT_LOADK(1, rk1);
  __syncthreads();
  ATT_STOREK(0, rk0);
  ATT_STOREK(1, rk1);
  ATT_LOADK(2, rk0);
  ATT_LOADV(0, rv0);
  __syncthreads();
  f32x16 st[2];
  ATT_QK(0);
  __syncthreads();
  bf16x8 pf[2][2];
#define ATT_ITER(it, PAR, RKL, RVL, RKS, RVS, DO_PV, DO_QK)                                                          \
  {                                                                                                                \
    if ((it) + 3 < ntiles) ATT_LOADK((it) + 3, RKL);                                                               \
    if ((it) + 1 < ntiles) ATT_LOADV((it) + 1, RVL);                                                               \
    if (DO_PV) ATT_PVH((PAR) ^ 1, 0);                                                                              \
    if (NAM) {                                                                                                     \
      _Pragma("unroll") for (int tt = 0; tt < 2; ++tt)                                                             \
        _Pragma("unroll") for (int i = 0; i < 16; ++i) {                                                           \
          const int kidx = key0 + (it) * 64 + 32 * tt + (i & 3) + 8 * (i >> 2) + 4 * h;                            \
          const int kr = kidx >> 6, kc = kidx & 63;                                                                \
          const bool valid = (kr >= r0) && (kr < r0 + 8) && (kc >= c0) && (kc < c0 + 16);                          \
          const int idx = valid ? (kr - qr + 7) * 31 + (kc - qc + 15) : 0;                                         \
          const float bias = rpb_l[idx];                                                                           \
          st[tt][i] = valid ? st[tt][i] + bias : -1e30f;                                                           \
        }                                                                                                          \
    }                                                                                                              \
    float mx = fmaxf(fmaxf(st[0][0], st[0][1]), st[0][2]);                                                         \
    _Pragma("unroll") for (int i = 3; i < 15; i += 2) mx = fmaxf(fmaxf(mx, st[0][i]), st[0][i + 1]);               \
    mx = fmaxf(fmaxf(mx, st[0][15]), st[1][0]);                                                                    \
    _Pragma("unroll") for (int i = 1; i < 15; i += 2) mx = fmaxf(fmaxf(mx, st[1][i]), st[1][i + 1]);               \
    mx = fmaxf(mx, st[1][15]);                                                                                     \
    mx = fmaxf(mx, shx(mx, 32)) - m_run;                                                                           \
    __builtin_amdgcn_sched_barrier(0);                                                                             \
    if (DO_PV) ATT_PVH((PAR) ^ 1, 1);                                                                              \
    _Pragma("unroll") for (int tt = 0; tt < 2; ++tt)                                                               \
      _Pragma("unroll") for (int i = 0; i < 16; ++i) st[tt][i] = __builtin_amdgcn_exp2f(st[tt][i] - m_run);        \
    if (__builtin_amdgcn_ballot_w64(mx > 8.f) != 0ull) {                                                           \
      const float delta = fmaxf(mx, 0.f);                                                                          \
      const float alpha = __builtin_amdgcn_exp2f(-delta);                                                          \
      m_run += delta;                                                                                              \
      _Pragma("unroll") for (int i = 0; i < 16; ++i) {                                                             \
        st[0][i] *= alpha; st[1][i] *= alpha;                                                                      \
        ot[0][i] *= alpha; ot[1][i] *= alpha; lsum[i] *= alpha;                                                    \
      }                                                                                                            \
    }                                                                                                              \
    _Pragma("unroll") for (int tt = 0; tt < 2; ++tt)                                                               \
      _Pragma("unroll") for (int s = 0; s < 2; ++s) pf[tt][s] = pack8(st[tt], 8 * s);                              \
    if (DO_QK) ATT_QK((PAR) ^ 1);                                                                                  \
    if ((it) + 2 < ntiles) ATT_STOREK(PAR, RKS);                                                                   \
    ATT_STOREV(PAR, RVS);                                                                                          \
    __syncthreads();                                                                                               \
  }
  ATT_ITER(0, 0, rk1, rv1, rk0, rv0, false, true);
#pragma unroll 1
  for (int it = 1; it < ntiles - 1; it += 2) {
    ATT_ITER(it, 1, rk0, rv0, rk1, rv1, true, true);
    ATT_ITER(it + 1, 0, rk1, rv1, rk0, rv0, true, true);
  }
  ATT_ITER(ntiles - 1, 1, rk0, rv0, rk1, rv1, true, false);
#undef ATT_ITER
  ATT_PV(1);
#undef ATT_LOADK
#undef ATT_LOADV
#undef ATT_STOREK
#undef ATT_STOREV
#undef ATT_QK
#undef ATT_PV
#undef ATT_PVH
}

template <int DK, bool NAM>
DI void attn_run(const bf16_t* Qn_w, const bf16_t* Qp_w, const bf16_t* Kbh, const bf16_t* Vtbh, int lat_key0, int lat_tiles, unsigned char* smem,
                 f32x16 (&ot)[2], int qr, int qc, const float* rpb_l) {
  const int lane = tid() & 63, l31 = lane & 31, h = lane >> 5;
  float m_run = 0.f;
  f32x16 lsum;
#pragma unroll
  for (int i = 0; i < 16; ++i) { ot[0][i] = 0.f; ot[1][i] = 0.f; lsum[i] = 0.f; }
  bf16x8 qf[DK / 16];
#pragma unroll
  for (int s = 0; s < DK / 16; ++s) qf[s] = *(const bf16x8*)(Qn_w + l31 * DK + 16 * s + 8 * h);
  attn_segment<DK, false>(qf, Kbh + (size_t)S * DK, Vtbh + S, CL / 64, smem, ot, m_run, lsum, qr, qc, 0, rpb_l);
  if (Qp_w) {
#pragma unroll
    for (int s = 0; s < DK / 16; ++s) qf[s] = *(const bf16x8*)(Qp_w + l31 * DK + 16 * s + 8 * h);
    attn_segment<DK, NAM>(qf, Kbh + (size_t)lat_key0 * DK, Vtbh + lat_key0, lat_tiles, smem, ot, m_run, lsum, qr, qc, lat_key0, rpb_l);
  }
  const float inv = 1.f / lsum[0];
#pragma unroll
  for (int d = 0; d < 2; ++d)
#pragma unroll
    for (int i = 0; i < 16; ++i) ot[d][i] *= inv;
}
DI void store_o(bf16_t* orow, const f32x16 (&ot)[2], int h) {
#pragma unroll
  for (int d = 0; d < 2; ++d)
#pragma unroll
    for (int g = 0; g < 4; ++g) {
      uint2 v; v.x = pk(ot[d][4 * g], ot[d][4 * g + 1]); v.y = pk(ot[d][4 * g + 2], ot[d][4 * g + 3]);
      *(uint2*)(orow + 32 * d + 8 * g + 4 * h) = v;
    }
}

DI bf16_t* att_orow(PR p, int b, int br, int head, int qoff, bool isc) {
  const int l31 = tid() & 31;
  const int mrow = isc ? (ML + b * CL + (qoff - S) + l31) : (b * S + qoff + l31);
  return (bf16_t*)(p.ws + OFF_BIG) + (size_t)mrow * D + br * 256 + head * 64;
}
template <class F>
DI void att_unit_loop(PR p, int layer, int br, int nunits, unsigned char* smem, int rep, F body) {
  const int t = tid(), wave = __builtin_amdgcn_readfirstlane(t >> 6);
  const int b = blockIdx.x & 7;
  int* cnt = (int*)(p.ws + OFF_CTRL) + (layer * 8 + b) * 4 + br + rep * 128;
  int* s_unit = (int*)(smem + A_UNIT);
  while (true) {
    __syncthreads();
    if (t == 0) *s_unit = atomicAdd(cnt, 1);
    __syncthreads();
    const int u = *s_unit;
    if (u >= nunits) break;
    const bool isc = u >= 64;
    const int head = isc ? ((u - 64) & 3) : (u >> 4);
    const int qoff = isc ? (S + wave * 32) : ((u & 15) * 256 + wave * 32);
    body(head, qoff, isc);
  }
}

DI void phase_attn(PR p, int layer, bool need_ctx, unsigned char* smem, int rep) {
  const int t = tid(), lane = t & 63, wave = __builtin_amdgcn_readfirstlane(t >> 6), l31 = lane & 31, h = lane >> 5;
  const int b = blockIdx.x & 7;
  const int nunits = need_ctx ? 68 : 64;
  float* rpb_l = (float*)(smem + A_RPB);
  att_unit_loop(p, layer, 3, nunits, smem, rep, [&](int head, int qoff, bool isc) {
    f32x16 o1[2];
    const bf16_t* qn = (const bf16_t*)(p.ws + OFF_M_QN) + ((size_t)(b * 4 + head) * KEYS + qoff) * 96;
    const bf16_t* qp = isc ? nullptr : (const bf16_t*)(p.ws + OFF_M_QP) + ((size_t)(b * 4 + head) * S + qoff) * 96;
    attn_run<96, false>(qn, qp, (const bf16_t*)(p.ws + OFF_M_K) + (size_t)(b * 4 + head) * KEYS * 96,
                        (const bf16_t*)(p.ws + OFF_M_VT) + (size_t)(b * 4 + head) * 64 * KEYS, 0, S / 64, smem, o1, 0, 0, rpb_l);
    store_o(att_orow(p, b, 3, head, qoff, isc), o1, h);
  });
  {
    att_unit_loop(p, layer, 2, nunits, smem, rep, [&](int head, int qoff, bool isc) {
      f32x16 o2[2];
      const bf16_t* vt = (const bf16_t*)(p.ws + OFF_D_VT) + (size_t)(b * 4 + head) * 64 * KEYS;
      float* scr = (float*)(p.ws + OFF_SCR) + (size_t)blockIdx.x * 16384 + t;
      {
        const int g = b * 8 + head * 2;
        const bf16_t* qn = (const bf16_t*)(p.ws + OFF_D_QN) + ((size_t)g * KEYS + qoff) * 32;
        const bf16_t* qp = isc ? nullptr : (const bf16_t*)(p.ws + OFF_D_QP) + ((size_t)g * S + qoff) * 32;
        attn_run<32, false>(qn, qp, (const bf16_t*)(p.ws + OFF_D_K) + (size_t)g * KEYS * 32, vt, 0, S / 64, smem, o2, 0, 0, rpb_l);
      }
#pragma unroll
      for (int d = 0; d < 2; ++d)
#pragma unroll
        for (int i = 0; i < 16; ++i) scr[(d * 16 + i) * NTHR] = o2[d][i];
      {
        const int g = b * 8 + head * 2 + 1;
        const bf16_t* qn = (const bf16_t*)(p.ws + OFF_D_QN) + ((size_t)g * KEYS + qoff) * 32;
        const bf16_t* qp = isc ? nullptr : (const bf16_t*)(p.ws + OFF_D_QP) + ((size_t)g * S + qoff) * 32;
        attn_run<32, false>(qn, qp, (const bf16_t*)(p.ws + OFF_D_K) + (size_t)g * KEYS * 32, vt, 0, S / 64, smem, o2, 0, 0, rpb_l);
      }
      const float lam = ((const float*)(p.ws + OFF_CTRL))[512 + layer];
      const float lam_init = 0.8f - 0.6f * expf(-0.3f * (float)layer);
      const float* gs = p.in[19] + layer * 64;
      const float* scr2 = (const float*)(p.ws + OFF_SCR) + (size_t)blockIdx.x * 16384 + tid();
      float ss = 0.f;
#pragma unroll
      for (int d = 0; d < 2; ++d)
#pragma unroll
        for (int i = 0; i < 16; ++i) { const float v = scr2[(d * 16 + i) * NTHR] - lam * o2[d][i]; o2[d][i] = v; ss += v * v; }
      ss += shx(ss, 32);
      const float rs = rsqrtf(ss * (1.f / 64.f) + EPS) * (1.f - lam_init);
#pragma unroll
      for (int d = 0; d < 2; ++d)
#pragma unroll
        for (int i = 0; i < 16; ++i) o2[d][i] *= rs * gs[32 * d + 8 * (i >> 2) + 4 * h + (i & 3)];
      store_o(att_orow(p, b, 2, head, qoff, isc), o2, h);
    });
  }
  att_unit_loop(p, layer, 1, nunits, smem, rep, [&](int head, int qoff, bool isc) {
    f32x16 o1[2];
    const bf16_t* qn = (const bf16_t*)(p.ws + OFF_G_QN) + ((size_t)(b * 4 + head) * KEYS + qoff) * 64;
    const bf16_t* qp = isc ? nullptr : (const bf16_t*)(p.ws + OFF_G_QP) + ((size_t)(b * 4 + head) * S + qoff) * 64;
    const int g = b * 2 + (head >> 1);
    attn_run<64, false>(qn, qp, (const bf16_t*)(p.ws + OFF_G_K) + (size_t)g * KEYS * 64,
                        (const bf16_t*)(p.ws + OFF_G_VT) + (size_t)g * 64 * KEYS, 0, S / 64, smem, o1, 0, 0, rpb_l);
    store_o(att_orow(p, b, 1, head, qoff, isc), o1, h);
  });
  att_unit_loop(p, layer, 0, nunits, smem, rep, [&](int head, int qoff, bool isc) {
    f32x16 o1[2];
    for (int i = t; i < 465; i += NTHR) rpb_l[i] = p.in[13][(size_t)(layer * 4 + head) * 465 + i] * LOG2E;
    const bf16_t* qn = (const bf16_t*)(p.ws + OFF_NA_Q) + ((size_t)(b * 4 + head) * KEYS + qoff) * 64;
    const int qidx = qoff + l31;
    const int qrow0 = (qoff - wave * 32) >> 6;
    const int rs = min(min(max(qrow0 - 4, 0), 56), 52);
    attn_run<64, true>(qn, isc ? nullptr : qn, (const bf16_t*)(p.ws + OFF_NA_K) + (size_t)(b * 4 + head) * KEYS * 64,
                       (const bf16_t*)(p.ws + OFF_NA_VT) + (size_t)(b * 4 + head) * 64 * KEYS, rs * 64, 12, smem, o1, qidx >> 6, qidx & 63, rpb_l);
    store_o(att_orow(p, b, 0, head, qoff, isc), o1, h);
  });
}

template <int MTW>
DI void merge_tiles(PR p, int layer, int mbase, int mtiles, unsigned char* smem) {
  const bf16_t* H = (const bf16_t*)(p.ws + OFF_H);
  const bf16_t* O = (const bf16_t*)(p.ws + OFF_BIG);
  bf16_t* Y = (bf16_t*)(p.ws + OFF_Y);
  const bf16_t* WG = (const bf16_t*)(p.ws + OFF_WG);
  const bf16_t* WB = (const bf16_t*)(p.ws + OFF_WB);
  const int ntiles = D / 256;
  const int total = mtiles * ntiles, chunk = total >> 3;
  const int xcd = blockIdx.x & 7, li = blockIdx.x >> 3, per = gridDim.x >> 3;
  const int lane = tid() & 63, wid = tid() >> 6, wr = wid >> 2, wc = wid & 3;
  for (int q = li; q < chunk; q += per) {
    const int T = xcd * chunk + q;
    const int mg = T / (8 * ntiles), rem = T % (8 * ntiles);
    const int m0 = mbase + (mg * 8 + (rem & 7)) * (MTW * 32), n0 = (rem >> 3) * 256;
    const int row0 = m0 + wr * (MTW * 16) + (lane & 15), col0 = n0 + wc * 64 + 4 * (lane >> 4);
    unsigned ypk[MTW][4][2];
#pragma unroll
    for (int i = 0; i < MTW; ++i)
#pragma unroll
      for (int j = 0; j < 4; ++j) { ypk[i][j][0] = 0u; ypk[i][j][1] = 0u; }
#pragma unroll 1
    for (int j = 0; j < 4; ++j) {
      f32x4 accG[MTW][4];
#pragma unroll
      for (int i = 0; i < MTW; ++i)
#pragma unroll
        for (int k = 0; k < 4; ++k) accG[i][k] = (f32x4){0.f, 0.f, 0.f, 0.f};
      const GSeg sgG{H, WG + (size_t)j * D * D, D, D, D >> 6, m0, n0}, sgB{O + j * 256, WB + (size_t)j * D * 256, D, 256, 4, m0, n0};
      GSeg nxG{H, WG + (size_t)(j + 1) * D * D, D, D, j < 3 ? (D >> 6) : 0, m0, n0};
      if (j == 3 && q + per < chunk) {
        const int T2 = T + per, mg2 = T2 / (8 * ntiles), rem2 = T2 % (8 * ntiles);
        nxG.Bt = WG; nxG.nk = D >> 6; nxG.m0 = mbase + (mg2 * 8 + (rem2 & 7)) * (MTW * 32); nxG.n0 = (rem2 >> 3) * 256;
      }
      gemm_mainloop<MTW>(sgG, sgB, smem, accG);
      unsigned gpk[MTW][4][2];
      const float* bg = p.in[27] + (size_t)(layer * 4 + j) * D + col0;
#pragma unroll
      for (int nt = 0; nt < 4; ++nt) {
        const float4 b4 = *(const float4*)(bg + 16 * nt);
#pragma unroll
        for (int mt = 0; mt < MTW; ++mt) {
          const float g0 = __builtin_amdgcn_rcpf(1.f + __expf(-(accG[mt][nt][0] + b4.x))), g1 = __builtin_amdgcn_rcpf(1.f + __expf(-(accG[mt][nt][1] + b4.y)));
          const float g2 = __builtin_amdgcn_rcpf(1.f + __expf(-(accG[mt][nt][2] + b4.z))), g3 = __builtin_amdgcn_rcpf(1.f + __expf(-(accG[mt][nt][3] + b4.w)));
          gpk[mt][nt][0] = pk(g0, g1); gpk[mt][nt][1] = pk(g2, g3);
        }
      }
#pragma unroll
      for (int i = 0; i < MTW; ++i)
#pragma unroll
        for (int k = 0; k < 4; ++k) accG[i][k] = (f32x4){0.f, 0.f, 0.f, 0.f};
      gemm_mainloop<MTW>(sgB, nxG, smem, accG);
#pragma unroll
      for (int mt = 0; mt < MTW; ++mt)
#pragma unroll
        for (int nt = 0; nt < 4; ++nt) {
          const float y0 = __uint_as_float(ypk[mt][nt][0] << 16) + __uint_as_float(gpk[mt][nt][0] << 16) * accG[mt][nt][0];
          const float y1 = __uint_as_float(ypk[mt][nt][0] & 0xffff0000u) + __uint_as_float(gpk[mt][nt][0] & 0xffff0000u) * accG[mt][nt][1];
          const float y2 = __uint_as_float(ypk[mt][nt][1] << 16) + __uint_as_float(gpk[mt][nt][1] << 16) * accG[mt][nt][2];
          const float y3 = __uint_as_float(ypk[mt][nt][1] & 0xffff0000u) + __uint_as_float(gpk[mt][nt][1] & 0xffff0000u) * accG[mt][nt][3];
          ypk[mt][nt][0] = pk(y0, y1); ypk[mt][nt][1] = pk(y2, y3);
        }
    }
#pragma unroll
    for (int mt = 0; mt < MTW; ++mt)
#pragma unroll
      for (int nt = 0; nt < 4; ++nt) {
        uint2 v; v.x = ypk[mt][nt][0]; v.y = ypk[mt][nt][1];
        *(uint2*)(Y + (size_t)(row0 + 16 * mt) * D + col0 + 16 * nt) = v;
      }
  }
}

#define XB_TMO      128
#define XB_XCNT(j)  (256  + 64 * (j))
#define XB_XSUB(j)  (1280 + 64 * (j))
#define XB_XGEN(j)  (2304 + 64 * (j))
#define XB_TOP      3328
#define XB_TOPGEN   3392
#define XCD_BAR_WORDS 3456
#define XB_SPIN_CAP (1u << 20)
#define LAS __attribute__((address_space(3)))
DI unsigned xb_ld(unsigned* p)              { return __hip_atomic_load(p, __ATOMIC_RELAXED, __HIP_MEMORY_SCOPE_AGENT); }
DI unsigned xb_add(unsigned* p, unsigned v) { return __hip_atomic_fetch_add(p, v, __ATOMIC_RELAXED, __HIP_MEMORY_SCOPE_AGENT); }
DI unsigned xb_xcc_id() { return (unsigned)__builtin_amdgcn_s_getreg((3 << 11) | 20) & 0xFu; }
#define XB_SPIN(cond, bar) do { unsigned _sp = 0; while (cond) { __builtin_amdgcn_s_sleep(1); \
    if ((++_sp & 255u) == 0u) { if (xb_ld(&(bar)[XB_TMO])) break; if (_sp > XB_SPIN_CAP) { atomicAdd(&(bar)[XB_TMO], 1u); break; } } } } while (0)
struct XcdBarrier { unsigned* bar; unsigned x; volatile LAS unsigned* st; };
DI XcdBarrier xcd_barrier_post(unsigned* bar, volatile LAS unsigned* st) {
  XcdBarrier b; b.bar = bar; b.x = xb_xcc_id(); b.st = st;
  if (threadIdx.x == 0) (void)xb_add(&bar[XB_XCNT(b.x)], 1u);
  return b;
}
DI void xcd_barrier_complete(unsigned* bar, unsigned x, unsigned& nloc, unsigned& nx) {
  const unsigned G = gridDim.x * gridDim.y * gridDim.z;
  unsigned sum, cnt, mine, sp = 0u;
  for (;;) {
    sum = 0u; cnt = 0u; mine = 0u;
#pragma unroll
    for (unsigned j = 0; j < 16; ++j) { const unsigned c = xb_ld(&bar[XB_XCNT(j)]); sum += c; cnt += (c > 0u) ? 1u : 0u; mine = (j == x) ? c : mine; }
    if (sum == G) break;
    __builtin_amdgcn_s_sleep(1);
    if ((++sp & 255u) == 0u) { if (xb_ld(&bar[XB_TMO])) break; if (sp > XB_SPIN_CAP) { atomicAdd(&bar[XB_TMO], 1u); break; } }
  }
  nloc = mine > 0u ? mine : 1u; nx = cnt > 0u ? cnt : 1u;
}
DI void xcd_barrier(const XcdBarrier& b) {
  asm volatile("s_waitcnt vmcnt(0)" ::: "memory");
  __syncthreads();
  if (threadIdx.x == 0) {
    unsigned* bar = b.bar;
    __builtin_amdgcn_s_waitcnt(0);
    unsigned nloc = b.st[0], nx = b.st[1];
    if (nloc == 0u) { xcd_barrier_complete(bar, b.x, nloc, nx); b.st[0] = nloc; b.st[1] = nx; }
    const unsigned old = xb_add(&bar[XB_XSUB(b.x)], 1u);
    const unsigned gen = old / nloc;
    if (old + 1u == (gen + 1u) * nloc) {
      __builtin_amdgcn_fence(__ATOMIC_RELEASE, "agent");
      asm volatile("s_waitcnt vmcnt(0)" ::: "memory");
      const unsigned og = xb_add(&bar[XB_TOP], 1u);
      const unsigned tg = og / nx;
      if (og + 1u == (tg + 1u) * nx) xb_add(&bar[XB_TOPGEN], 1u);
      else XB_SPIN(xb_ld(&bar[XB_TOPGEN]) == tg, bar);
      __builtin_amdgcn_fence(__ATOMIC_ACQUIRE, "agent");
      xb_add(&bar[XB_XGEN(b.x)], 1u);
      asm volatile("s_waitcnt vmcnt(0)" ::: "memory");
    } else {
      XB_SPIN(xb_ld(&bar[XB_XGEN(b.x)]) == gen, bar);
      __builtin_amdgcn_fence(__ATOMIC_ACQUIRE, "agent");
      asm volatile("s_waitcnt vmcnt(0)" ::: "memory");
    }
  }
  __syncthreads();
}

DI void phase_merge(PR p, int layer, int mrows, unsigned char* smem) {
  merge_tiles<4>(p, layer, 0, ML / 128, smem);
  if (mrows > ML) merge_tiles<2>(p, layer, ML, MC / 64, smem);
}

DI void ctr_barrier(unsigned* ctr, unsigned& epoch) {
  asm volatile("s_waitcnt vmcnt(0)" ::: "memory");
  __syncthreads();
  epoch += 1u;
  if (threadIdx.x == 0) {
    __builtin_amdgcn_fence(__ATOMIC_RELEASE, "agent");
    asm volatile("s_waitcnt vmcnt(0)" ::: "memory");
    (void)xb_add(ctr, 1u);
    const unsigned target = epoch * gridDim.x;
    unsigned sp = 0u;
    while (xb_ld(ctr) < target) { __builtin_amdgcn_s_sleep(1); if (++sp > (1u << 22)) break; }
    __builtin_amdgcn_fence(__ATOMIC_ACQUIRE, "agent");
    asm volatile("s_waitcnt vmcnt(0)" ::: "memory");
  }
  __syncthreads();
}

#ifndef RP_UP
#define RP_UP 0
#endif
#ifndef RP_DOWN
#define RP_DOWN 0
#endif
#ifndef RP_WIN
#define RP_WIN 0
#endif
#ifndef RP_MERGE
#define RP_MERGE 0
#endif
#ifndef RP_OUT
#define RP_OUT 0
#endif
#ifndef RP_ATTN
#define RP_ATTN 0
#endif
#ifndef RP_TOK
#define RP_TOK 0
#endif
#ifndef RP_NORM
#define RP_NORM RP_TOK
#endif
#ifndef RP_QKV
#define RP_QKV RP_TOK
#endif
#ifndef RP_MLAUP
#define RP_MLAUP RP_TOK
#endif
#ifndef RP_MLAPOST
#define RP_MLAPOST RP_TOK
#endif
#ifndef RP_SYNC
#define RP_SYNC 0
#endif
__global__ void __launch_bounds__(512, 2) fwd_megakernel(Params p) {
  cg::grid_group grid = cg::this_grid();
  __shared__ __attribute__((aligned(1024))) unsigned char smem[LDS_BYTES];
  KP kp = (KP)__builtin_amdgcn_kernarg_segment_ptr();
#define P_ (*({ asm volatile("" : "+s"(kp)); kp; }))
  __shared__ uint4 xb_words;
  if (threadIdx.x == 0) xb_words = make_uint4(0u, 0u, 0u, 0u);
  __syncthreads();
  unsigned* const xb = (unsigned*)(kp->ws + OFF_BAR) + 256;
  if (blockIdx.x == 0) for (int i = threadIdx.x; i < XCD_BAR_WORDS; i += NTHR) xb[i - 256] = 0u;
  phase_prologue(P_, smem);
  grid.sync();
  unsigned bar_epoch = 0;
#pragma unroll 1
  for (int layer = 0; layer < DEPTH; ++layer) {
    const bool need_ctx = layer < DEPTH - 1;
    const int mlate = need_ctx ? MT : ML;
    if (layer > 0) conv_ffn(P_, layer, 1, smem);
    for (int r = 0; r <= RP_NORM; ++r) { phase_norm(P_, layer, 0, 0, 1, MT, layer == 0); ctr_barrier(xb, bar_epoch); }
    for (int r = 0; r <= RP_UP; ++r) { phase_ffn_up(P_, 0, MT, smem); ctr_barrier(xb, bar_epoch); }
    for (int r = 0; r <= RP_DOWN; ++r) {
      phase_gemm_res(P_, layer, (const bf16_t*)(P_.ws + OFF_BIG), DFF, (const bf16_t*)(P_.ws + OFF_W2A), DFF, 2, r ? 0.f : 0.5f, MT, smem, layer == 0 && r == 0);
      ctr_barrier(xb, bar_epoch);
    }
    if (layer + 1 < DEPTH) conv_ffn(P_, layer + 1, 0, smem);
    for (int r = 0; r <= RP_NORM; ++r) { phase_norm(P_, layer, 1, 3, 4, MT); ctr_barrier(xb, bar_epoch); }
    for (int r = 0; r <= RP_WIN; ++r) { phase_win(P_, smem); ctr_barrier(xb, bar_epoch); }
    for (int r = 0; r <= RP_QKV; ++r) { phase_qkv(P_, layer, smem); ctr_barrier(xb, bar_epoch); }
    for (int r = 0; r <= RP_MLAUP; ++r) { phase_mla_up(P_, smem); ctr_barrier(xb, bar_epoch); }
    for (int r = 0; r < RP_SYNC; ++r) ctr_barrier(xb, bar_epoch);
    for (int r = 0; r <= RP_MLAPOST; ++r) { phase_mla_post(P_, layer, smem); ctr_barrier(xb, bar_epoch); }
    for (int r = 0; r <= RP_ATTN; ++r) { phase_attn(P_, layer, need_ctx, smem, r); ctr_barrier(xb, bar_epoch); }
    for (int r = 0; r <= RP_MERGE; ++r) { phase_merge(P_, layer, mlate, smem); ctr_barrier(xb, bar_epoch); }
    for (int r = 0; r <= RP_OUT; ++r) {
      phase_gemm_res(P_, layer, (const bf16_t*)(P_.ws + OFF_Y), D, (const bf16_t*)(P_.ws + OFF_WO), D, 5, r ? 0.f : 1.0f, mlate, smem);
      ctr_barrier(xb, bar_epoch);
    }
    if (layer + 1 < DEPTH) conv_mixer(P_, layer + 1, smem);
    for (int r = 0; r <= RP_NORM; ++r) { phase_norm(P_, layer, 2, 6, 7, mlate); ctr_barrier(xb, bar_epoch); }
    for (int r = 0; r <= RP_UP; ++r) { phase_ffn_up(P_, 1, mlate, smem); ctr_barrier(xb, bar_epoch); }
    for (int r = 0; r <= RP_DOWN; ++r) {
      phase_gemm_res(P_, layer, (const bf16_t*)(P_.ws + OFF_BIG), DFF, (const bf16_t*)(P_.ws + OFF_W2B), DFF, 8, r ? 0.f : 0.5f, mlate, smem);
      if (layer + 1 < DEPTH || r < RP_DOWN) ctr_barrier(xb, bar_epoch);
    }
  }
}

extern "C" void kernel_launch(void* const* d_in, const int* in_sizes, int n_in, void* d_out, int out_size,
                              void* d_ws, size_t ws_size, hipStream_t stream) {
  static int grid_blocks = 0;
  if (!grid_blocks) {
    int dev = 0, cus = 0, per_cu = 0;
    (void)hipGetDevice(&dev);
    (void)hipDeviceGetAttribute(&cus, hipDeviceAttributeMultiprocessorCount, dev);
    (void)hipOccupancyMaxActiveBlocksPerMultiprocessor(&per_cu, fwd_megakernel, 512, 0);
    if (per_cu > 1) per_cu = 1;
    if (per_cu < 1) per_cu = 1;
    grid_blocks = cus * per_cu;
    if (ws_size < WS_NEED) fprintf(stderr, "workspace too small: %zu < %zu\n", ws_size, (size_t)WS_NEED);
  }
  Params p{};
  for (int i = 0; i < 30; ++i) p.in[i] = (const float*)d_in[i];
  p.out = (float*)d_out;
  p.ws = (unsigned char*)d_ws;
  void* args[] = {&p};
  hipError_t e = hipLaunchCooperativeKernel((void*)fwd_megakernel, dim3(grid_blocks), dim3(512), args, 0, stream);
  if (e != hipSuccess) fprintf(stderr, "cooperative launch failed: %s (grid %d)\n", hipGetErrorString(e), grid_blocks);
}
```
